# Optimizing an MI355X kernel written in HIP

```python
import math
import jax, jax.numpy as jnp
from jax import lax
import numpy as np

D_MODEL = 1024
BATCH = 4
SEQ = 8192
DEPTH = 2

GLA_HEADS = 4
GLA_DK = 64
GLA_DV = 128
GLA_QK_DIM = GLA_HEADS * GLA_DK
GLA_V_DIM = GLA_HEADS * GLA_DV
GATE_RANK = 16
GATE_NORMALIZER = 16.0
CHUNK = 64
CONV_DIM = 512
CONV_WIDTH = 3
IN_SPLITS = (GLA_QK_DIM, GLA_QK_DIM, GLA_V_DIM, GLA_V_DIM, GATE_RANK, CONV_DIM, CONV_DIM, CONV_DIM)
IN_DIM = sum(IN_SPLITS)
MIX_DIM = GLA_V_DIM + CONV_DIM
FFN_HIDDEN = int(math.ceil(8 * D_MODEL / 3 / 256) * 256)
PLE_DIM = 256
NORM_EPS = 1e-6

kernel_name = "hybrid_gla_shortconv_parallel_heads"


def _rmsnorm(x, g):
    xf = x.astype(jnp.float32)
    xf = xf * lax.rsqrt(jnp.mean(xf * xf, axis=-1, keepdims=True) + NORM_EPS)
    return (xf * g.astype(jnp.float32)).astype(x.dtype)


def _gla_chunked(q, k, v, log_a):
    b_, s_, h_, dk = q.shape
    dv = v.shape[-1]
    n = s_ // CHUNK

    def to_chunks(t):
        return t.reshape(b_, n, CHUNK, h_, t.shape[-1]).transpose(1, 0, 3, 2, 4)

    causal = jnp.tril(jnp.ones((CHUNK, CHUNK), dtype=bool))[:, :, None]

    def step(state, inp):
        qc, kc, vc, gc = inp
        bcum = jnp.cumsum(gc, axis=2)
        diff = bcum[:, :, :, None, :] - bcum[:, :, None, :, :]
        decay = jnp.where(causal, jnp.exp(jnp.where(causal, diff, 0.0)), 0.0)
        scores = jnp.einsum('bhtd,bhsd,bhtsd->bhts', qc, kc, decay)
        o_intra = jnp.einsum('bhts,bhsv->bhtv', scores, vc)
        o_inter = jnp.einsum('bhtd,bhdv->bhtv', qc * jnp.exp(bcum), state)
        b_last = bcum[:, :, -1, :]
        k_dec = kc * jnp.exp(b_last[:, :, None, :] - bcum)
        new_state = jnp.exp(b_last)[..., None] * state + jnp.einsum('bhsd,bhsv->bhdv', k_dec, vc)
        return new_state, o_intra + o_inter

    s0 = jnp.zeros((b_, h_, dk, dv), jnp.float32)
    _, o = lax.scan(step, s0, (to_chunks(q), to_chunks(k), to_chunks(v), to_chunks(log_a)))
    return o.transpose(1, 0, 3, 2, 4).reshape(b_, s_, h_, dv)


def _causal_depthwise_conv(u, w):
    return lax.conv_general_dilated(
        u, w[:, None, :].astype(u.dtype), window_strides=(1,),
        padding=[(CONV_WIDTH - 1, 0)],
        dimension_numbers=('NWC', 'WIO', 'NWC'),
        feature_group_count=u.shape[-1])


def setup_inputs(seed: int = 0) -> dict:
    key = jax.random.key(seed)
    ks = jax.random.split(key, 20)
    nrm = lambda k, shape, scale: jax.random.normal(k, shape, jnp.float32) * scale
    gain = lambda k, shape: 1.0 + 0.05 * jax.random.normal(k, shape, jnp.float32)
    return {
        "x": nrm(ks[0], (BATCH, SEQ, D_MODEL), 1.0),
        "p": nrm(ks[1], (DEPTH, BATCH, SEQ, PLE_DIM), 1.0),
        "ln1_g": gain(ks[2], (DEPTH, D_MODEL)),
        "w_in": nrm(ks[3], (DEPTH, D_MODEL, IN_DIM), D_MODEL ** -0.5),
        "w_gate_up": nrm(ks[4], (DEPTH, GATE_RANK, GLA_QK_DIM), GATE_RANK ** -0.5),
        "b_gate": nrm(ks[5], (DEPTH, GLA_QK_DIM), 0.1),
        "conv_w": nrm(ks[6], (DEPTH, CONV_WIDTH, CONV_DIM), CONV_WIDTH ** -0.5),
        "gn_g": gain(ks[7], (DEPTH, GLA_DV)),
        "w_out": nrm(ks[8], (DEPTH, MIX_DIM, D_MODEL), MIX_DIM ** -0.5),
        "ln2_g": gain(ks[9], (DEPTH, D_MODEL)),
        "w_gate_upffn": nrm(ks[10], (DEPTH, D_MODEL, 2 * FFN_HIDDEN), D_MODEL ** -0.5),
        "w_down": nrm(ks[11], (DEPTH, FFN_HIDDEN, D_MODEL), FFN_HIDDEN ** -0.5),
        "ln3_g": gain(ks[12], (DEPTH, D_MODEL)),
        "w_ple_gate": nrm(ks[13], (DEPTH, D_MODEL, D_MODEL), D_MODEL ** -0.5),
        "w_ple_proj": nrm(ks[14], (DEPTH, PLE_DIM, D_MODEL), PLE_DIM ** -0.5),
        "lnf_g": gain(ks[15], (D_MODEL,)),
    }


def reference(x, p, ln1_g, w_in, w_gate_up, b_gate, conv_w, gn_g, w_out, ln2_g,
              w_gate_upffn, w_down, ln3_g, w_ple_gate, w_ple_proj, lnf_g):
    b_, s_, _ = x.shape
    offsets = list(np.cumsum(IN_SPLITS)[:-1])
    h = x
    for i in range(DEPTH):
        u = _rmsnorm(h, ln1_g[i])
        proj = u @ w_in[i]
        q, k, v, g, g_lr, cb, cc, cx = jnp.split(proj, offsets, axis=-1)

        gate_logits = (g_lr @ w_gate_up[i] + b_gate[i]).astype(jnp.float32)
        log_a = jax.nn.log_sigmoid(gate_logits) / GATE_NORMALIZER
        qh = q.astype(jnp.float32).reshape(b_, s_, GLA_HEADS, GLA_DK) * (GLA_DK ** -0.5)
        kh = k.astype(jnp.float32).reshape(b_, s_, GLA_HEADS, GLA_DK)
        vh = v.astype(jnp.float32).reshape(b_, s_, GLA_HEADS, GLA_DV)
        ah = log_a.reshape(b_, s_, GLA_HEADS, GLA_DK)
        o = _gla_chunked(qh, kh, vh, ah).astype(x.dtype)
        gh = g.reshape(b_, s_, GLA_HEADS, GLA_DV)
        o = _rmsnorm(o, gn_g[i]) * jax.nn.silu(gh)
        o = o.reshape(b_, s_, GLA_V_DIM)

        y = cb * _causal_depthwise_conv(cc * cx, conv_w[i])

        mix = jnp.concatenate([o, y], axis=-1) @ w_out[i]
        h = h + mix

        u2 = _rmsnorm(h, ln2_g[i])
        a, bb = jnp.split(u2 @ w_gate_upffn[i], 2, axis=-1)
        h = h + (jax.nn.silu(a) * bb) @ w_down[i]

        u3 = _rmsnorm(h, ln3_g[i])
        gate = jax.nn.sigmoid(u3 @ w_ple_gate[i])
        h = h + gate * (p[i] @ w_ple_proj[i])
    return _rmsnorm(h, lnf_g)
```

```cpp
#include <hip/hip_runtime.h>
#include <cstdio>
#include <cstdint>
namespace pg8 {
#define PG8_LAS __attribute__((address_space(3)))
typedef unsigned short bf16_t;
typedef short bf16x8 __attribute__((ext_vector_type(8)));
typedef float f32x4 __attribute__((ext_vector_type(4)));
typedef unsigned u32x4 __attribute__((ext_vector_type(4)));
constexpr int BM = 256, BK = 64, HALF = 128, HTB = HALF * BK * 2  , STAGE_BYTES = 8 * HTB, NXCD = 8, WGM = 8;

__host__ __device__ __forceinline__ int lds_byte(int r, int c) { const int st = (r >> 4) * 2 + (c >> 5), rr = r & 15, cc = c & 31, ob = rr * 64 + cc * 2; return st * 1024 + (ob ^ (((ob >> 9) & 1) << 5)); }
__host__ __device__ __forceinline__ void stage_rc(int b, int& R, int& C) { const int st = b / 1024, sb = b % 1024, swz = sb ^ (((sb >> 9) & 1) << 5); R = (st >> 1) * 16 + swz / 64; C = (st & 1) * 32 + (swz % 64) / 2; }
__host__ __device__ __forceinline__ int perm32(int rho) { const int n = rho >> 4, i = rho & 15; return 8 * (i >> 2) + 4 * n + (i & 3); }

struct Unit { int pm, pn; };
struct Gemm { const bf16_t* A; const bf16_t* Bt; int M, N, K; };

struct StaticOrder {
    int nM, nN, nwg, G, c;
    __host__ __device__ void init(int M, int N, int G_, int c_) { nM = M / BM; nN = N / BM; nwg = nM * nN; G = G_; c = c_; }
    __host__ __device__ bool next(int i, Unit& u) const {
        const long L = (long)i * G + c; if (L >= nwg) return false;
        int wgid = (int)L; { const int q = nwg / NXCD, r = nwg % NXCD, xcd = wgid % NXCD, off = wgid / NXCD; wgid = (xcd < r ? xcd * (q + 1) : r * (q + 1) + (xcd - r) * q) + off; }
        const int nig = WGM * nN, gid = wgid / nig, fm = gid * WGM, gsz = (nM - fm) < WGM ? (nM - fm) : WGM;
        u.pm = fm + ((wgid % nig) % gsz); u.pn = (wgid % nig) / gsz; return true;
    }
    __device__ __forceinline__ void a_ready(const Unit&) const {}
    __device__ __forceinline__ void done(const Unit&) const {}
};


__device__ __forceinline__ unsigned cvt_pk_bf16(float lo, float hi) { unsigned r; asm volatile("v_cvt_pk_bf16_f32 %0, %1, %2" : "=v"(r) : "v"(lo), "v"(hi)); return r; }
typedef unsigned u32x2 __attribute__((ext_vector_type(2)));
constexpr float RMS_EPS = 1e-6f;
__device__ __forceinline__ float fast_rcp(float x) { return __builtin_amdgcn_rcpf(x); }
__device__ __forceinline__ float fast_exp(float x) { return __builtin_amdgcn_exp2f(x * 1.4426950408889634f); }
__device__ __forceinline__ float fast_log(float x) { return __builtin_amdgcn_logf(x) * 0.6931471805599453f; }
__device__ __forceinline__ float sigmoidf_(float x) { return fast_rcp(1.0f + fast_exp(-x)); }
__device__ __forceinline__ float siluf_(float x) { return x * sigmoidf_(x); }
__device__ __forceinline__ float logsig16(float x) { return (fminf(x, 0.f) - fast_log(1.0f + fast_exp(-fabsf(x)))) * 0.0625f; }
__device__ __forceinline__ float rstd_from(const float* ssq, int row) { const f32x4 s = *(const f32x4*)(ssq + (size_t)row * 4); return 1.0f / sqrtf(((s[0] + s[1]) + (s[2] + s[3])) * (1.0f / 1024.0f) + RMS_EPS); }

struct EpiProj {
    static constexpr bool PERM = true, AFTER_DRAIN = false;
    bf16_t* O; int ldc; const float* ssq; const float* bgate; int gate_pn;
    __device__ __forceinline__ void operator()(const f32x4 (&acc)[2][2][4][2], const Unit& u, int wr, int wc, int fr, int fq) const {
        const int row0 = u.pm * BM + wr * 64 + fr, col0 = u.pn * BM + wc * 32 + 8 * fq;
        const bool isg = (u.pn == gate_pn);
        f32x4 bv[2][2];
#pragma unroll
        for (int bj = 0; bj < 2; ++bj)
#pragma unroll
            for (int n = 0; n < 2; ++n) bv[bj][n] = isg ? *(const f32x4*)(bgate + wc * 32 + 8 * fq + bj * HALF + 4 * n) : (f32x4){0.f, 0.f, 0.f, 0.f};
#pragma unroll
        for (int ai = 0; ai < 2; ++ai)
#pragma unroll
            for (int m = 0; m < 4; ++m) { const int row = row0 + ai * HALF + m * 16; const float rs = rstd_from(ssq, row); bf16_t* rowp = O + (size_t)row * ldc + col0;
#pragma unroll
                for (int bj = 0; bj < 2; ++bj) { f32x4 v0 = acc[ai][bj][m][0] * rs, v1 = acc[ai][bj][m][1] * rs;
                    if (isg) { v0 = v0 + bv[bj][0]; v1 = v1 + bv[bj][1];
#pragma unroll
                        for (int i = 0; i < 4; ++i) { v0[i] = logsig16(v0[i]); v1[i] = logsig16(v1[i]); } }
                    u32x4 w; w.x = cvt_pk_bf16(v0[0], v0[1]); w.y = cvt_pk_bf16(v0[2], v0[3]); w.z = cvt_pk_bf16(v1[0], v1[1]); w.w = cvt_pk_bf16(v1[2], v1[3]);
                    *(u32x4*)(rowp + bj * HALF) = w; } }
    }
};
struct EpiSwiGLU {
    static constexpr bool PERM = true, AFTER_DRAIN = false;
    bf16_t* O; int ldc; const float* ssq;
    __device__ __forceinline__ void operator()(const f32x4 (&acc)[2][2][4][2], const Unit& u, int wr, int wc, int fr, int fq) const {
        const int row0 = u.pm * BM + wr * 64 + fr, col0 = u.pn * HALF + wc * 32 + 8 * fq;
#pragma unroll
        for (int ai = 0; ai < 2; ++ai)
#pragma unroll
            for (int m = 0; m < 4; ++m) { const int row = row0 + ai * HALF + m * 16; const float rs = rstd_from(ssq, row);
                f32x4 h0, h1;
#pragma unroll
                for (int i = 0; i < 4; ++i) { h0[i] = siluf_(acc[ai][0][m][0][i] * rs) * (acc[ai][1][m][0][i] * rs); h1[i] = siluf_(acc[ai][0][m][1][i] * rs) * (acc[ai][1][m][1][i] * rs); }
                u32x4 w; w.x = cvt_pk_bf16(h0[0], h0[1]); w.y = cvt_pk_bf16(h0[2], h0[3]); w.z = cvt_pk_bf16(h1[0], h1[1]); w.w = cvt_pk_bf16(h1[2], h1[3]);
                *(u32x4*)(O + (size_t)row * ldc + col0) = w; }
    }
};
struct EpiPP {
    static constexpr bool PERM = false, AFTER_DRAIN = false;
    bf16_t* O; int ldc;
    __device__ __forceinline__ void operator()(const f32x4 (&acc)[2][2][4][2], const Unit& u, int wr, int wc, int fr, int fq) const {
        const int row0 = u.pm * BM + wr * 64 + fr, col0 = u.pn * BM + wc * 32 + 4 * fq;
#pragma unroll
        for (int ai = 0; ai < 2; ++ai)
#pragma unroll
            for (int m = 0; m < 4; ++m) { bf16_t* rowp = O + (size_t)(row0 + ai * HALF + m * 16) * ldc + col0;
#pragma unroll
                for (int bj = 0; bj < 2; ++bj)
#pragma unroll
                    for (int n = 0; n < 2; ++n) { const f32x4 v = acc[ai][bj][m][n]; u32x2 w; w.x = cvt_pk_bf16(v[0], v[1]); w.y = cvt_pk_bf16(v[2], v[3]); *(u32x2*)(rowp + bj * HALF + n * 16) = w; } }
    }
};
template <int MODE> struct EpiRes {
    static constexpr bool PERM = false, AFTER_DRAIN = false;
    const float* base; float* out; bf16_t* hb; float* ssq_out; const float* ssq_in; const bf16_t* pp; PG8_LAS float* scr; int tid;
    __device__ __forceinline__ void operator()(const f32x4 (&acc_)[2][2][4][2], const Unit& u, int wr, int wc, int fr, int fq) const {
        f32x4 (&acc)[2][2][4][2] = const_cast<f32x4 (&)[2][2][4][2]>(acc_);
        const int col0 = u.pn * BM + wc * 32 + 4 * fq;
        if (MODE == 1) {
#pragma unroll
            for (int ai = 0; ai < 2; ++ai)
#pragma unroll
                for (int m = 0; m < 4; ++m) { const int row = u.pm * BM + ai * HALF + wr * 64 + m * 16 + fr; const bf16_t* pr = pp + (size_t)row * 1024 + col0;
                    const float rs = rstd_from(ssq_in, row);
#pragma unroll
                    for (int bj = 0; bj < 2; ++bj)
#pragma unroll
                        for (int n = 0; n < 2; ++n) { const u32x2 pw = *(const u32x2*)(pr + bj * HALF + n * 16); f32x4 v = acc[ai][bj][m][n];
                            v[0] = sigmoidf_(v[0] * rs) * __uint_as_float(pw.x << 16); v[1] = sigmoidf_(v[1] * rs) * __uint_as_float(pw.x & 0xffff0000u);
                            v[2] = sigmoidf_(v[2] * rs) * __uint_as_float(pw.y << 16); v[3] = sigmoidf_(v[3] * rs) * __uint_as_float(pw.y & 0xffff0000u); acc[ai][bj][m][n] = v; }
                    asm volatile("" : "+v"(acc[ai][0][m][0]), "+v"(acc[ai][0][m][1]), "+v"(acc[ai][1][m][0]), "+v"(acc[ai][1][m][1]));
                    asm volatile("" ::: "memory"); }
        }
#pragma unroll
        for (int ai = 0; ai < 2; ++ai)
#pragma unroll
            for (int m = 0; m < 4; ++m) { const int rl = ai * HALF + wr * 64 + m * 16 + fr, row = u.pm * BM + rl; const size_t off = (size_t)row * 1024 + col0;
                float part = 0.f;
#pragma unroll
                for (int bj = 0; bj < 2; ++bj)
#pragma unroll
                    for (int n = 0; n < 2; ++n) { const size_t c = off + bj * HALF + n * 16; const f32x4 v = acc[ai][bj][m][n];
                        const f32x4 b = *(const f32x4*)(base + c); const f32x4 o = b + v; *(f32x4*)(out + c) = o;
                        if (hb) { u32x2 w; w.x = cvt_pk_bf16(o[0], o[1]); w.y = cvt_pk_bf16(o[2], o[3]); *(u32x2*)(hb + c) = w; }
                        part += (o[0] * o[0] + o[1] * o[1]) + (o[2] * o[2] + o[3] * o[3]); }
                part += __shfl_xor(part, 16); part += __shfl_xor(part, 32);
                if (fq == 0) scr[rl * 4 + wc] = part;
                if (m & 1) asm volatile("" ::: "memory"); }
        asm volatile("s_waitcnt lgkmcnt(0)" ::: "memory"); __builtin_amdgcn_s_barrier(); asm volatile("" ::: "memory");
        { const int t = tid & 255;
          if (t < 128) { const int rl = (t >> 6) * HALF + wr * 64 + (t & 63); const f32x4 p4 = *(const PG8_LAS f32x4*)(scr + rl * 4);
              ssq_out[(size_t)(u.pm * BM + rl) * 4 + u.pn] = (p4[0] + p4[1]) + (p4[2] + p4[3]); } }
        asm volatile("s_waitcnt lgkmcnt(0)" ::: "memory");
    }
};
template <class Epi, class Sched, bool ALIGN_EPI = false, bool SP2 = false>
__device__ __forceinline__ void gemm_phase(PG8_LAS unsigned char* lds, const Gemm g, const Sched& S, const Epi& E, const int tid) {
    const int wid = __builtin_amdgcn_readfirstlane(tid >> 6), lane = tid & 63, wr = wid >> 2, wc = wid & 3, fr = lane & 15, fq = lane >> 4;
    const int K = g.K, nt = K / BK;
    unsigned voffA[2], voffB[2];
#pragma unroll
    for (int i = 0; i < 2; ++i) { int R, C; stage_rc(tid * 16 + i * 8192, R, C); const int Rb = Epi::PERM ? ((R & ~31) + perm32(R & 31)) : R;
        voffA[i] = (unsigned)(R * K + C) * 2u; voffB[i] = (unsigned)(Rb * K + C) * 2u; }
    const size_t kstep = (size_t)(BK * 2);
    const size_t hstep = (size_t)HALF * K * 2;
    const size_t tstep = 2 * hstep;
    const unsigned ldsw = (unsigned)wid * 1024u;
    const int aoff = lds_byte(wr * 64 + fr, fq * 8), boff = lds_byte(wc * 32 + fr, fq * 8);
#define PG8_SA(b, h) (((b) * 2 + (h)) * HTB)
#define PG8_SB(b, h) ((4 + (b) * 2 + (h)) * HTB)
#define PG8_STAGE(bufoff, gbase, voff) do { _Pragma("unroll") for (int _i = 0; _i < 2; ++_i) \
        __builtin_amdgcn_global_load_lds((const unsigned*)((const char*)(gbase) + (voff)[_i]), (PG8_LAS unsigned*)(lds + (bufoff) + ldsw + _i * 8192), 16, 0, 0); } while (0)
#define PG8_LDA(dst, b, h) do { _Pragma("unroll") for (int m = 0; m < 4; ++m) _Pragma("unroll") for (int k = 0; k < 2; ++k) dst[m][k] = *(const PG8_LAS bf16x8*)(lds + PG8_SA(b, h) + aoff + m * 2048 + k * 1024); } while (0)
#define PG8_LDB(dst, b, h) do { _Pragma("unroll") for (int n = 0; n < 2; ++n) _Pragma("unroll") for (int k = 0; k < 2; ++k) dst[n][k] = *(const PG8_LAS bf16x8*)(lds + PG8_SB(b, h) + boff + n * 2048 + k * 1024); } while (0)
#define PG8_MMA(ai, bj, At, Bt) do { __builtin_amdgcn_s_setprio(1); _Pragma("unroll") for (int m = 0; m < 4; ++m) _Pragma("unroll") for (int n = 0; n < 2; ++n) _Pragma("unroll") for (int k = 0; k < 2; ++k) \
        acc[ai][bj][m][n] = __builtin_amdgcn_mfma_f32_16x16x32_bf16(Bt[n][k], At[m][k], acc[ai][bj][m][n], 0, 0, 0); __builtin_amdgcn_s_setprio(0); } while (0)
#define PG8_WAIT_V(n) asm volatile("s_waitcnt vmcnt(" #n ")" ::: "memory")
#define PG8_WAIT_L(n) asm volatile("s_waitcnt lgkmcnt(" #n ")" ::: "memory")
#define PG8_BAR __builtin_amdgcn_s_barrier()
#define PG8_SCHED __builtin_amdgcn_sched_barrier(0)
    Unit cur, nxt; int ui = 0;
    if (!S.next(0, cur)) return;
    f32x4 acc[2][2][4][2];
#pragma unroll
    for (int a = 0; a < 2; ++a)
#pragma unroll
        for (int b = 0; b < 2; ++b)
#pragma unroll
            for (int m = 0; m < 4; ++m)
#pragma unroll
                for (int n = 0; n < 2; ++n) acc[a][b][m][n] = (f32x4){0.f, 0.f, 0.f, 0.f};
    bf16x8 At[4][2], B0[2][2], B1[2][2];
    const char* cA = (const char*)g.A + (size_t)cur.pm * tstep; const char* cB = (const char*)g.Bt + (size_t)cur.pn * tstep;
    S.a_ready(cur);
    if constexpr (SP2) {
        PG8_STAGE(PG8_SB(0, 0), cB, voffB); PG8_STAGE(PG8_SB(0, 1), cB + hstep, voffB); PG8_STAGE(PG8_SA(0, 0), cA, voffA); PG8_STAGE(PG8_SA(0, 1), cA + hstep, voffA);
        if (wr == 1) PG8_BAR;
        PG8_WAIT_V(2); PG8_BAR;
        PG8_STAGE(PG8_SB(1, 0), cB + kstep, voffB); PG8_STAGE(PG8_SA(1, 0), cA + kstep, voffA); PG8_STAGE(PG8_SB(1, 1), cB + hstep + kstep, voffB);
        PG8_WAIT_V(6); PG8_BAR;
    } else {
        PG8_STAGE(PG8_SB(0, 0), cB, voffB); PG8_STAGE(PG8_SA(0, 0), cA, voffA); PG8_STAGE(PG8_SB(0, 1), cB + hstep, voffB); PG8_STAGE(PG8_SA(0, 1), cA + hstep, voffA);
        if (wr == 1) PG8_BAR;
        PG8_WAIT_V(4); PG8_BAR;
        PG8_STAGE(PG8_SB(1, 0), cB + kstep, voffB); PG8_STAGE(PG8_SA(1, 0), cA + kstep, voffA); PG8_STAGE(PG8_SB(1, 1), cB + hstep + kstep, voffB);
        PG8_WAIT_V(6); PG8_BAR;
    }
    for (;;) {
        const bool has_next = S.next(ui + 1, nxt);
        const char* nA = has_next ? (const char*)g.A + (size_t)nxt.pm * tstep : cA; const char* nB = has_next ? (const char*)g.Bt + (size_t)nxt.pn * tstep : cB;
        for (int t = 0; t < nt; t += 2) {
            const bool last = (t == nt - 2);
            const char* a1 = cA + (size_t)(t + 1) * kstep;
            const char* a2 = last ? nA : cA + (size_t)(t + 2) * kstep; const char* b2 = last ? nB : cB + (size_t)(t + 2) * kstep;
            const char* a3 = a2 + kstep; const char* b3 = b2 + kstep;
            if (last && has_next) S.a_ready(nxt);
            if constexpr (SP2) {
            PG8_LDB(B0, 0, 0); PG8_LDB(B1, 0, 1); PG8_SCHED; PG8_LDA(At, 0, 0); PG8_STAGE(PG8_SA(1, 1), a1 + hstep, voffA);
            PG8_WAIT_V(8); PG8_WAIT_L(0); PG8_BAR; PG8_MMA(0, 0, At, B0); PG8_MMA(0, 1, At, B1); PG8_BAR; PG8_SCHED;
            PG8_LDA(At, 0, 1); PG8_STAGE(PG8_SB(0, 0), b2, voffB); PG8_STAGE(PG8_SB(0, 1), b2 + hstep, voffB); PG8_STAGE(PG8_SA(0, 0), a2, voffA);
            PG8_WAIT_V(8); PG8_WAIT_L(0); PG8_BAR; PG8_MMA(1, 0, At, B0); PG8_MMA(1, 1, At, B1); PG8_BAR; PG8_SCHED;
            PG8_LDB(B0, 1, 0); PG8_LDB(B1, 1, 1); PG8_SCHED; PG8_LDA(At, 1, 0); PG8_STAGE(PG8_SA(0, 1), a2 + hstep, voffA);
            PG8_WAIT_V(8); PG8_WAIT_L(0); PG8_BAR; PG8_MMA(0, 0, At, B0); PG8_MMA(0, 1, At, B1); PG8_BAR; PG8_SCHED;
            PG8_LDA(At, 1, 1); PG8_STAGE(PG8_SB(1, 0), b3, voffB); PG8_STAGE(PG8_SB(1, 1), b3 + hstep, voffB); PG8_STAGE(PG8_SA(1, 0), a3, voffA);
            PG8_WAIT_V(8); PG8_WAIT_L(0); PG8_BAR; PG8_MMA(1, 0, At, B0); PG8_MMA(1, 1, At, B1); PG8_BAR; PG8_SCHED;
            } else {
            PG8_LDB(B0, 0, 0); PG8_SCHED; PG8_LDA(At, 0, 0); PG8_STAGE(PG8_SA(1, 1), a1 + hstep, voffA);
            PG8_WAIT_L(8); PG8_BAR; PG8_WAIT_L(0); PG8_MMA(0, 0, At, B0); PG8_BAR; PG8_SCHED;
            PG8_LDB(B1, 0, 1); PG8_STAGE(PG8_SB(0, 0), b2, voffB);
            PG8_BAR; PG8_WAIT_L(0); PG8_MMA(0, 1, At, B1); PG8_BAR;
            PG8_LDA(At, 0, 1); PG8_STAGE(PG8_SA(0, 0), a2, voffA);
            PG8_BAR; PG8_WAIT_L(0); PG8_MMA(1, 0, At, B0); PG8_BAR; PG8_SCHED;
            PG8_STAGE(PG8_SB(0, 1), b2 + hstep, voffB);
            PG8_WAIT_V(6); PG8_BAR; PG8_MMA(1, 1, At, B1); PG8_BAR;
            PG8_LDB(B0, 1, 0); PG8_SCHED; PG8_LDA(At, 1, 0); PG8_STAGE(PG8_SA(0, 1), a2 + hstep, voffA);
            PG8_WAIT_L(8); PG8_BAR; PG8_WAIT_L(0); PG8_MMA(0, 0, At, B0); PG8_BAR; PG8_SCHED;
            PG8_LDB(B1, 1, 1); PG8_STAGE(PG8_SB(1, 0), b3, voffB);
            PG8_BAR; PG8_WAIT_L(0); PG8_MMA(0, 1, At, B1); PG8_BAR;
            PG8_LDA(At, 1, 1); PG8_STAGE(PG8_SA(1, 0), a3, voffA);
            PG8_BAR; PG8_WAIT_L(0); PG8_MMA(1, 0, At, B0); PG8_BAR; PG8_SCHED;
            PG8_STAGE(PG8_SB(1, 1), b3 + hstep, voffB);
            PG8_WAIT_V(6); PG8_BAR; PG8_MMA(1, 1, At, B1); PG8_BAR;
            }
        }
        if constexpr (ALIGN_EPI) { if (wr == 0) PG8_BAR; }
        if constexpr (!Epi::AFTER_DRAIN) { E(acc, cur, wr, wc, fr, fq); S.done(cur); }
        if (!has_next) break;
#pragma unroll
        for (int a = 0; a < 2; ++a)
#pragma unroll
            for (int b = 0; b < 2; ++b)
#pragma unroll
                for (int m = 0; m < 4; ++m)
#pragma unroll
                    for (int n = 0; n < 2; ++n) acc[a][b][m][n] = (f32x4){0.f, 0.f, 0.f, 0.f};
        cur = nxt; cA = nA; cB = nB; ++ui;
        if constexpr (ALIGN_EPI) { if (wr == 1) PG8_BAR; }
    }
    PG8_WAIT_V(0);
    if constexpr (!ALIGN_EPI) { if (wr == 0) PG8_BAR; }
    PG8_BAR;
    if constexpr (Epi::AFTER_DRAIN) { E.fused(acc, cur, wr, wc, fr, fq, lds, wid, lane); S.done(cur); }
#undef PG8_SA
#undef PG8_SB
#undef PG8_STAGE
#undef PG8_LDA
#undef PG8_LDB
#undef PG8_MMA
#undef PG8_WAIT_V
#undef PG8_WAIT_L
#undef PG8_BAR
#undef PG8_SCHED
}
}

constexpr int NWAVES = 8;
constexpr int BATCH = 4, SEQ = 8192, DM = 1024, DEPTH = 2, M = BATCH * SEQ;
constexpr int NH = 4, DK = 64, DV = 128, CHUNK = 64, NCH = SEQ / CHUNK;
constexpr int NITEM = BATCH * NH * NCH;
constexpr int IN_DIM = 3088, FFN = 2816, PLE = 256, CONVD = 512;
constexpr int PS = 3328;
constexpr int PC_Q = 0, PC_K = 256, PC_V = 512, PC_G = 1024, PC_CB = 1536, PC_CC = 2048, PC_CX = 2560, PC_LA = 3072;
constexpr int N_PHASES = 18;

constexpr size_t MiB = 1u << 20;
constexpr size_t WS_CTL = 0, CTL_ZERO_BYTES = 1 * MiB;
constexpr size_t WS_SSQ0 = 1 * MiB, WS_SSQ1 = 1 * MiB + 512 * 1024;
constexpr size_t WS_DECAY = 2 * MiB;
constexpr size_t WS_W = 4 * MiB, W_LAYER = 28 * MiB;
constexpr size_t WO_IN = 0, WO_OUT = 6815744, WO_GU = WO_OUT + 2 * MiB, WO_DN = WO_GU + 11 * MiB, WO_PG = WO_DN + 5767168, WO_PP = WO_PG + 2 * MiB;
static_assert(WO_PP + 512 * 1024 <= W_LAYER, "weights per layer");
constexpr size_t WS_HB = 64 * MiB;
constexpr size_t WS_PROJ = 128 * MiB;
constexpr size_t WS_U = 336 * MiB;
constexpr size_t WS_S = 400 * MiB;
constexpr size_t WS_PB = 432 * MiB;
constexpr size_t WS_END = 464 * MiB;
constexpr int CW_BAR = 4096;

constexpr int RING_OFF = 0, RING_BYTES = 131072;
constexpr int EPI_SCR_OFF = RING_BYTES;
constexpr int LDSCTL_OFF = RING_BYTES + 4096, MISC_OFF = LDSCTL_OFF + 320;
constexpr int LDS_BYTES = 147456;
constexpr int G_TOT = 0, G_QT = 2048, G_KT = 12288, G_VT = 24576, G_ST = 45056, G_OST = 65536;
constexpr int QK_STRIDE = 144, KD_STRIDE = 192, V_STRIDE = 320, OST_STRIDE = 528;

#define GAS __attribute__((address_space(1)))
#define LAS __attribute__((address_space(3)))
typedef unsigned short bf16;
typedef unsigned v4u __attribute__((ext_vector_type(4)));
typedef unsigned v2u __attribute__((ext_vector_type(2)));
typedef float f32x4 __attribute__((ext_vector_type(4)));
typedef float f32x16 __attribute__((ext_vector_type(16)));
typedef short bf16x8 __attribute__((ext_vector_type(8)));
typedef short s16x4 __attribute__((ext_vector_type(4)));
typedef GAS unsigned gu32;
#define RLX_AGENT __ATOMIC_RELAXED, __HIP_MEMORY_SCOPE_AGENT
#define LDS_WAIT() asm volatile("s_waitcnt lgkmcnt(0)" ::: "memory")
#define VM_WAIT() asm volatile("s_waitcnt vmcnt(0)" ::: "memory")
using pg8::cvt_pk_bf16; using pg8::fast_exp; using pg8::fast_rcp; using pg8::siluf_;
__device__ __forceinline__ float bf_lo(unsigned w) { return __uint_as_float(w << 16); }
__device__ __forceinline__ float bf_hi(unsigned w) { return __uint_as_float(w & 0xffff0000u); }
__device__ __forceinline__ void unpack8(const v4u& w, float (&f)[8]) { f[0] = bf_lo(w.x); f[1] = bf_hi(w.x); f[2] = bf_lo(w.y); f[3] = bf_hi(w.y); f[4] = bf_lo(w.z); f[5] = bf_hi(w.z); f[6] = bf_lo(w.w); f[7] = bf_hi(w.w); }
__device__ __forceinline__ v4u pack8(const float (&f)[8]) { v4u w; w.x = cvt_pk_bf16(f[0], f[1]); w.y = cvt_pk_bf16(f[2], f[3]); w.z = cvt_pk_bf16(f[4], f[5]); w.w = cvt_pk_bf16(f[6], f[7]); return w; }
#define XB_TMO      128
#define XB_XCNT(j)  (256  + 64 * (j))
#define XB_XSUB(j)  (1280 + 64 * (j))
#define XB_XGEN(j)  (2304 + 64 * (j))
#define XB_TOP      3328
#define XB_TOPGEN   3392
#define XCD_BAR_WORDS 3456
#define XB_SPIN_CAP (1u << 18)

__device__ __forceinline__ unsigned xb_ld(unsigned* p)              { return __hip_atomic_load(p, __ATOMIC_RELAXED, __HIP_MEMORY_SCOPE_AGENT); }
__device__ __forceinline__ unsigned xb_add(unsigned* p, unsigned v) { return __hip_atomic_fetch_add(p, v, __ATOMIC_RELAXED, __HIP_MEMORY_SCOPE_AGENT); }
__device__ __forceinline__ unsigned xb_xcc_id() { return (unsigned)__builtin_amdgcn_s_getreg((3 << 11) | 20) & 0xFu; }
#define XB_SPIN(cond, bar) do { unsigned _sp = 0; while (cond) { __builtin_amdgcn_s_sleep(1); \
    if ((++_sp & 255u) == 0u) { if (xb_ld(&(bar)[XB_TMO])) break; if (_sp > XB_SPIN_CAP) { atomicAdd(&(bar)[XB_TMO], 1u); break; } } } } while (0)

struct XcdBarrier {
    unsigned* bar; unsigned x;
    volatile LAS unsigned* st;
};

__device__ __forceinline__ XcdBarrier xcd_barrier_post(unsigned* bar, volatile LAS unsigned* st) {
    XcdBarrier b; b.bar = bar; b.x = xb_xcc_id(); b.st = st;
    if (threadIdx.x == 0) (void)xb_add(&bar[XB_XCNT(b.x)], 1u);
    return b;
}
__device__ __forceinline__ void xcd_barrier_complete(unsigned* bar, unsigned x, unsigned& nloc, unsigned& nx) {
    const unsigned G = gridDim.x * gridDim.y * gridDim.z;
    unsigned sum, cnt, mine, sp = 0u;
    for (;;) {
        sum = 0u; cnt = 0u; mine = 0u;
#pragma unroll
        for (unsigned j = 0; j < 16; ++j) { const unsigned c = xb_ld(&bar[XB_XCNT(j)]); sum += c; cnt += (c > 0u) ? 1u : 0u; mine = (j == x) ? c : mine; }
        if (sum == G) break;
        __builtin_amdgcn_s_sleep(1);
        if ((++sp & 255u) == 0u) { if (xb_ld(&bar[XB_TMO])) break; if (sp > XB_SPIN_CAP) { atomicAdd(&bar[XB_TMO], 1u); break; } }
    }
    nloc = mine > 0u ? mine : 1u; nx = cnt > 0u ? cnt : 1u;
}

__device__ __forceinline__ void xcd_barrier(const XcdBarrier& b) {
    asm volatile("s_waitcnt vmcnt(0)" ::: "memory");
    __syncthreads();
    if (threadIdx.x == 0) {
        unsigned* bar = b.bar;
        __builtin_amdgcn_s_waitcnt(0);
        unsigned nloc = b.st[0], nx = b.st[1];
        if (nloc == 0u) { xcd_barrier_complete(bar, b.x, nloc, nx); b.st[0] = nloc; b.st[1] = nx; }
        const unsigned old = xb_add(&bar[XB_XSUB(b.x)], 1u);
        const unsigned gen = old / nloc;
        if (old + 1u == (gen + 1u) * nloc) {
            __builtin_amdgcn_fence(__ATOMIC_RELEASE, "agent");
            asm volatile("s_waitcnt vmcnt(0)" ::: "memory");
            const unsigned og = xb_add(&bar[XB_TOP], 1u);
            const unsigned tg = og / nx;
            if (og + 1u == (tg + 1u) * nx) xb_add(&bar[XB_TOPGEN], 1u);
            else XB_SPIN(xb_ld(&bar[XB_TOPGEN]) == tg, bar);
            __builtin_amdgcn_fence(__ATOMIC_ACQUIRE, "agent");
            xb_add(&bar[XB_XGEN(b.x)], 1u);
            asm volatile("s_waitcnt vmcnt(0)" ::: "memory");
        } else {
            XB_SPIN(xb_ld(&bar[XB_XGEN(b.x)]) == gen, bar);
            __builtin_amdgcn_fence(__ATOMIC_ACQUIRE, "agent");
            asm volatile("s_waitcnt vmcnt(0)" ::: "memory");
        }
    }
    __syncthreads();
}

struct Args { const float* in[16]; float* out; unsigned char* ws; int ph_lo, ph_hi; };
struct Frame {
    LAS unsigned char* lds;
    gu32* ctl;
    int tid, lane, wave;
    int G;
    const struct Args* ap;
    float* out; unsigned char* ws;
};
__device__ __forceinline__ bf16* w_ptr(const Frame& F, int L, size_t off) { return (bf16*)(F.ws + WS_W + (size_t)L * W_LAYER + off); }
__device__ __forceinline__ float wave_sum(float v) {
#pragma unroll
    for (int o = 1; o < 64; o <<= 1) v += __shfl_xor(v, o);
    return v;
}
__device__ __forceinline__ s16x4 tr_read(LAS unsigned char* p) { typedef short v4i16_t __attribute__((ext_vector_type(4))); return __builtin_bit_cast(s16x4, __builtin_amdgcn_ds_read_tr16_b64_v4i16((LAS v4i16_t*)p)); }
__device__ __forceinline__ bf16x8 cat8(s16x4 lo, s16x4 hi) { return (bf16x8){lo[0], lo[1], lo[2], lo[3], hi[0], hi[1], hi[2], hi[3]}; }

__device__ __forceinline__ void tr_item(const float* W, int ldw, int scol0, const float* gk, float cmul, bf16* WT, int K, int drow0, int k0, LAS float* scr, int lane) {
#pragma unroll 8
    for (int i = 0; i < 32; ++i) { const int kk = 2 * i + (lane >> 5); const float g = gk ? gk[k0 + kk] : 1.0f; scr[kk * 33 + (lane & 31)] = W[(size_t)(k0 + kk) * ldw + scol0 + (lane & 31)] * (g * cmul); }
    LDS_WAIT(); asm volatile("" ::: "memory");
    const int c = lane & 7;
#pragma unroll
    for (int j = 0; j < 4; ++j) { const int n = (lane >> 3) + 8 * j; const LAS float* s = scr + (8 * c) * 33 + n;
        v4u o; o.x = cvt_pk_bf16(s[0 * 33], s[1 * 33]); o.y = cvt_pk_bf16(s[2 * 33], s[3 * 33]); o.z = cvt_pk_bf16(s[4 * 33], s[5 * 33]); o.w = cvt_pk_bf16(s[6 * 33], s[7 * 33]);
        *(GAS v4u*)(WT + (size_t)(drow0 + n) * K + k0 + 8 * c) = o; }
    LDS_WAIT(); asm volatile("" ::: "memory");
}
__device__ __forceinline__ void p0_prologue(Frame& F) {
    LAS float* scr = (LAS float*)(F.lds + RING_OFF + F.wave * 16384);
    const int gw = blockIdx.x * NWAVES + F.wave, NGW = F.G * NWAVES;
    constexpr int I_IN = 16 * 96, I_OUT = 16 * 32, I_GU = 16 * 176, I_DN = 44 * 32, I_PG = 16 * 32, I_PP = 4 * 32;
    constexpr int I_LAYER = I_IN + I_OUT + I_GU + I_DN + I_PG + I_PP;
    for (int it = gw; it < DEPTH * I_LAYER; it += NGW) {
        const int L = it / I_LAYER; int r = it % I_LAYER;
        if (r < I_IN) { const int kb = r / 96, nb = r % 96, n0 = 32 * nb; const int sc = n0 < 1536 ? n0 : n0 + 16;
            tr_item(F.ap->in[3] + (size_t)L * DM * IN_DIM, IN_DIM, sc, F.ap->in[2] + L * DM, n0 < 256 ? 0.125f : 1.0f, w_ptr(F, L, WO_IN), 1024, n0, 64 * kb, scr, F.lane); continue; } r -= I_IN;
        if (r < I_OUT) { const int kb = r / 32, nb = r % 32;
            tr_item(F.ap->in[8] + (size_t)L * 1024 * 1024, 1024, 32 * nb, nullptr, 1.0f, w_ptr(F, L, WO_OUT), 1024, 32 * nb, 64 * kb, scr, F.lane); continue; } r -= I_OUT;
        if (r < I_GU) { const int kb = r / 176, nb = r % 176, n0 = 32 * nb; const int pn = n0 >> 8, bj = (n0 >> 7) & 1; const int sc = bj * FFN + 128 * pn + (n0 & 127);
            tr_item(F.ap->in[10] + (size_t)L * DM * 2 * FFN, 2 * FFN, sc, F.ap->in[9] + L * DM, 1.0f, w_ptr(F, L, WO_GU), 1024, n0, 64 * kb, scr, F.lane); continue; } r -= I_GU;
        if (r < I_DN) { const int kb = r / 32, nb = r % 32;
            tr_item(F.ap->in[11] + (size_t)L * FFN * DM, DM, 32 * nb, nullptr, 1.0f, w_ptr(F, L, WO_DN), FFN, 32 * nb, 64 * kb, scr, F.lane); continue; } r -= I_DN;
        if (r < I_PG) { const int kb = r / 32, nb = r % 32;
            tr_item(F.ap->in[13] + (size_t)L * DM * DM, DM, 32 * nb, F.ap->in[12] + L * DM, 1.0f, w_ptr(F, L, WO_PG), 1024, 32 * nb, 64 * kb, scr, F.lane); continue; } r -= I_PG;
        { const int kb = r / 32, nb = r % 32;
            tr_item(F.ap->in[14] + (size_t)L * PLE * DM, DM, 32 * nb, nullptr, 1.0f, w_ptr(F, L, WO_PP), PLE, 32 * nb, 64 * kb, scr, F.lane); }
    }
    const int gt = blockIdx.x * (NWAVES * 64) + F.tid, NGT = F.G * NWAVES * 64;
    for (int it = gt; it < DEPTH * 256 * 128; it += NGT) {
        const int L = it >> 15, r = it & 32767, n = r >> 7, k0 = (r & 127) * 8;
        const float* win = F.ap->in[3] + (size_t)L * DM * IN_DIM; const float* wgu = F.ap->in[4] + (size_t)L * 16 * 256 + n; const float* g1 = F.ap->in[2] + L * DM;
        float wg[16];
#pragma unroll
        for (int rr = 0; rr < 16; ++rr) wg[rr] = wgu[rr * 256];
        float o[8];
#pragma unroll
        for (int kk = 0; kk < 8; ++kk) { const float* wr_ = win + (size_t)(k0 + kk) * IN_DIM + 1536; float s = 0.f;
#pragma unroll
            for (int rr = 0; rr < 16; ++rr) s += wr_[rr] * wg[rr];
            o[kk] = s * g1[k0 + kk]; }
        *(GAS v4u*)(w_ptr(F, L, WO_IN) + (size_t)(3072 + n) * 1024 + k0) = pack8(o);
    }
    bf16* HB = (bf16*)(F.ws + WS_HB); float* SSQ0 = (float*)(F.ws + WS_SSQ0);
    for (int m = gw; m < M; m += NGW) {
        const GAS f32x4* xr = (const GAS f32x4*)(F.ap->in[0] + (size_t)m * DM) + F.lane; f32x4 v[4]; float s = 0.f;
#pragma unroll
        for (int j = 0; j < 4; ++j) { v[j] = xr[64 * j]; s += (v[j][0] * v[j][0] + v[j][1] * v[j][1]) + (v[j][2] * v[j][2] + v[j][3] * v[j][3]); }
        s = wave_sum(s);
        GAS v2u* o8 = (GAS v2u*)(HB + (size_t)m * DM) + F.lane;
#pragma unroll
        for (int j = 0; j < 4; ++j) { v2u w; w.x = cvt_pk_bf16(v[j][0], v[j][1]); w.y = cvt_pk_bf16(v[j][2], v[j][3]); o8[64 * j] = w; }
        if (F.lane == 0) *(GAS f32x4*)(SSQ0 + (size_t)m * 4) = (f32x4){s, 0.f, 0.f, 0.f};
    }
    bf16* PB = (bf16*)(F.ws + WS_PB);
    for (size_t i = (size_t)gt; i < (size_t)DEPTH * M * PLE / 8; i += (size_t)NGT) {
        const GAS f32x4* s = (const GAS f32x4*)(F.ap->in[1]) + 2 * i; const f32x4 a = s[0], b = s[1];
        v4u w; w.x = cvt_pk_bf16(a[0], a[1]); w.y = cvt_pk_bf16(a[2], a[3]); w.z = cvt_pk_bf16(b[0], b[1]); w.w = cvt_pk_bf16(b[2], b[3]);
        *((GAS v4u*)PB + i) = w;
    }
}

__device__ __forceinline__ void gla_prefix(const v4u& la, LAS unsigned char* lds, int wid, int lane, float (&bc)[8], float (&tot)[8]) {
    float c[8]; unpack8(la, c);
#pragma unroll
    for (int off = 8; off < 64; off <<= 1)
#pragma unroll
        for (int j = 0; j < 8; ++j) { const float v = __shfl_up(c[j], off); if (lane >= off) c[j] += v; }
    LAS float* T = (LAS float*)(lds + G_TOT);
    const int d0 = 8 * (lane & 7);
    if (lane >= 56) { *(LAS f32x4*)(T + wid * 64 + d0) = (f32x4){c[0], c[1], c[2], c[3]}; *(LAS f32x4*)(T + wid * 64 + d0 + 4) = (f32x4){c[4], c[5], c[6], c[7]}; }
    LDS_WAIT(); __syncthreads();
    float off[8];
#pragma unroll
    for (int j = 0; j < 8; ++j) { off[j] = 0.f; tot[j] = 0.f; }
#pragma unroll
    for (int w = 0; w < 8; ++w) { const f32x4 a = *(LAS f32x4*)(T + w * 64 + d0), b = *(LAS f32x4*)(T + w * 64 + d0 + 4);
        const float tv[8] = {a[0], a[1], a[2], a[3], b[0], b[1], b[2], b[3]};
#pragma unroll
        for (int j = 0; j < 8; ++j) { tot[j] += tv[j]; if (w < wid) off[j] += tv[j]; } }
#pragma unroll
    for (int j = 0; j < 8; ++j) bc[j] = off[j] + c[j];
}

__device__ __forceinline__ void gla_p1(Frame& F, int L) {
    const bf16* PROJ = (const bf16*)(F.ws + WS_PROJ); float* U = (float*)(F.ws + WS_U); float* DEC = (float*)(F.ws + WS_DECAY);
    LAS unsigned char* lds = F.lds + RING_OFF; const int wid = F.wave, lane = F.lane, tid = F.tid;
    const int t = 8 * wid + (lane >> 3), d0 = 8 * (lane & 7);
    const int r = lane & 31, hh = lane >> 5, g1 = (lane >> 4) & 1, q = (lane & 15) >> 2, p = lane & 3;
    const int dkt = wid >> 2, dvt = wid & 3;
    for (int item = blockIdx.x; item < NITEM; item += F.G) {
        const int bh = item >> 7, n = item & 127, b = bh >> 2, h = bh & 3; const size_t tok0 = (size_t)b * SEQ + (size_t)n * CHUNK;
        const bf16* row = PROJ + (tok0 + t) * PS;
        const v4u la = *(const GAS v4u*)(row + PC_LA + 64 * h + d0);
        const v4u kk = *(const GAS v4u*)(row + PC_K + 64 * h + d0);
        v4u vv[2];
#pragma unroll
        for (int i = 0; i < 2; ++i) vv[i] = *(const GAS v4u*)(PROJ + (tok0 + 32 * i + (tid >> 4)) * PS + PC_V + 128 * h + 8 * (tid & 15));
#pragma unroll
        for (int i = 0; i < 2; ++i) *(LAS v4u*)(lds + G_VT + (32 * i + (tid >> 4)) * V_STRIDE + (tid & 15) * 16) = vv[i];
        float bc[8], tot[8]; gla_prefix(la, lds, wid, lane, bc, tot);
        float kf[8]; unpack8(kk, kf);
#pragma unroll
        for (int j = 0; j < 8; ++j) kf[j] *= fast_exp(tot[j] - bc[j]);
        *(LAS v4u*)(lds + G_KT + t * KD_STRIDE + d0 * 2) = pack8(kf);
        if (tid < 8) { GAS f32x4* dp = (GAS f32x4*)(DEC + (size_t)item * 64 + d0); dp[0] = (f32x4){fast_exp(tot[0]), fast_exp(tot[1]), fast_exp(tot[2]), fast_exp(tot[3])}; dp[1] = (f32x4){fast_exp(tot[4]), fast_exp(tot[5]), fast_exp(tot[6]), fast_exp(tot[7])}; }
        LDS_WAIT(); __syncthreads();
        f32x16 acc;
#pragma unroll
        for (int i = 0; i < 16; ++i) acc[i] = 0.f;
#pragma unroll
        for (int ks = 0; ks < 4; ++ks) { const int rw = 16 * ks + 8 * hh + q;
            LAS unsigned char* ap = lds + G_KT + rw * KD_STRIDE + (32 * dkt + 16 * g1 + 4 * p) * 2;
            LAS unsigned char* bp = lds + G_VT + rw * V_STRIDE + (32 * dvt + 16 * g1 + 4 * p) * 2;
            const bf16x8 a = cat8(tr_read(ap), tr_read(ap + 4 * KD_STRIDE)), bb = cat8(tr_read(bp), tr_read(bp + 4 * V_STRIDE));
            acc = __builtin_amdgcn_mfma_f32_32x32x16_bf16(a, bb, acc, 0, 0, 0); }
        float* Up = U + (size_t)item * 8192 + (size_t)(32 * dkt + 4 * hh) * 128 + 32 * dvt + r;
#pragma unroll
        for (int i = 0; i < 16; ++i) Up[((i & 3) + 8 * (i >> 2)) * 128] = acc[i];
        __syncthreads();
    }
}

__device__ __forceinline__ void gla_p2(Frame& F) {
    const float* U = (const float*)(F.ws + WS_U); const float* DEC = (const float*)(F.ws + WS_DECAY); bf16* S = (bf16*)(F.ws + WS_S);
    const int gt = blockIdx.x * (NWAVES * 64) + F.tid, NGT = F.G * NWAVES * 64;
    for (int e = gt; e < BATCH * NH * 8192; e += NGT) {
        const int bh = e >> 13, idx = e & 8191, dk = idx >> 7;
        const float* Up = U + (size_t)bh * NCH * 8192 + idx; const float* dp = DEC + (size_t)bh * NCH * 64 + dk; bf16* Sp = S + (size_t)bh * NCH * 8192 + idx;
        float s = 0.f;
        for (int n0 = 0; n0 < NCH; n0 += 16) {
            float u[16], d[16];
#pragma unroll
            for (int i = 0; i < 16; ++i) { u[i] = Up[(size_t)(n0 + i) * 8192]; d[i] = dp[(n0 + i) * 64]; }
#pragma unroll
            for (int i = 0; i < 16; ++i) { Sp[(size_t)(n0 + i) * 8192] = (bf16)(cvt_pk_bf16(s, 0.f) & 0xffffu); s = d[i] * s + u[i]; }
        }
    }
}

__device__ __forceinline__ void gla_p3(Frame& F, int L) {
    const bf16* PROJ = (const bf16*)(F.ws + WS_PROJ); const bf16* S = (const bf16*)(F.ws + WS_S); bf16* MIX = (bf16*)(F.ws + WS_U);
    const float* gn = F.ap->in[7] + L * DV; const float* cw = F.ap->in[6] + (size_t)L * 3 * CONVD;
    LAS unsigned char* lds = F.lds + RING_OFF; const int wid = F.wave, lane = F.lane, tid = F.tid;
    const int t = 8 * wid + (lane >> 3), d0 = 8 * (lane & 7);
    const int r = lane & 31, hh = lane >> 5, g1 = (lane >> 4) & 1, q = (lane & 15) >> 2, p = lane & 3;
    const int tt = wid >> 2, dvt = wid & 3;
    for (int item = blockIdx.x; item < NITEM; item += F.G) {
        const int bh = item >> 7, n = item & 127, b = bh >> 2, h = bh & 3; const size_t tok0 = (size_t)b * SEQ + (size_t)n * CHUNK;
        const bf16* row = PROJ + (tok0 + t) * PS;
        const v4u la = *(const GAS v4u*)(row + PC_LA + 64 * h + d0);
        const v4u qq = *(const GAS v4u*)(row + PC_Q + 64 * h + d0);
        const v4u kk = *(const GAS v4u*)(row + PC_K + 64 * h + d0);
        { v4u vv[2], ss[2];
#pragma unroll
          for (int i = 0; i < 2; ++i) { vv[i] = *(const GAS v4u*)(PROJ + (tok0 + 32 * i + (tid >> 4)) * PS + PC_V + 128 * h + 8 * (tid & 15));
                                        ss[i] = *(const GAS v4u*)(S + (size_t)item * 8192 + (size_t)(32 * i + (tid >> 4)) * 128 + 8 * (tid & 15)); }
#pragma unroll
          for (int i = 0; i < 2; ++i) { *(LAS v4u*)(lds + G_VT + (32 * i + (tid >> 4)) * V_STRIDE + (tid & 15) * 16) = vv[i];
                                        *(LAS v4u*)(lds + G_ST + (32 * i + (tid >> 4)) * V_STRIDE + (tid & 15) * 16) = ss[i]; } }
        float bc[8], tot[8]; gla_prefix(la, lds, wid, lane, bc, tot);
        { float qf[8], kf[8]; unpack8(qq, qf); unpack8(kk, kf);
#pragma unroll
          for (int j = 0; j < 8; ++j) { const float e = fast_exp(bc[j]); qf[j] *= e; kf[j] *= fast_rcp(e); }
          *(LAS v4u*)(lds + G_QT + t * QK_STRIDE + d0 * 2) = pack8(qf);
          *(LAS v4u*)(lds + G_KT + t * QK_STRIDE + d0 * 2) = pack8(kf); }
        LDS_WAIT(); __syncthreads();
        f32x16 o;
#pragma unroll
        for (int i = 0; i < 16; ++i) o[i] = 0.f;
        bf16x8 qfr[4];
#pragma unroll
        for (int ks = 0; ks < 4; ++ks) qfr[ks] = *(LAS bf16x8*)(lds + G_QT + (32 * tt + r) * QK_STRIDE + (16 * ks + 8 * hh) * 2);
#pragma unroll
        for (int ks = 0; ks < 4; ++ks) { LAS unsigned char* bp = lds + G_ST + (16 * ks + 8 * hh + q) * V_STRIDE + (32 * dvt + 16 * g1 + 4 * p) * 2;
            const bf16x8 sb = cat8(tr_read(bp), tr_read(bp + 4 * V_STRIDE));
            o = __builtin_amdgcn_mfma_f32_32x32x16_bf16(qfr[ks], sb, o, 0, 0, 0); }
        for (int st = 0; st <= tt; ++st) {
            f32x16 x;
#pragma unroll
            for (int i = 0; i < 16; ++i) x[i] = 0.f;
#pragma unroll
            for (int ks = 0; ks < 4; ++ks) { const bf16x8 ka = *(LAS bf16x8*)(lds + G_KT + (32 * st + r) * QK_STRIDE + (16 * ks + 8 * hh) * 2);
                x = __builtin_amdgcn_mfma_f32_32x32x16_bf16(ka, qfr[ks], x, 0, 0, 0); }
            if (st == tt) {
#pragma unroll
                for (int i = 0; i < 16; ++i) { const int sl = (i & 3) + 8 * (i >> 2) + 4 * hh; if (sl > r) x[i] = 0.f; } }
#pragma unroll
            for (int k2 = 0; k2 < 2; ++k2) {
                v4u pw; pw.x = cvt_pk_bf16(x[8 * k2 + 0], x[8 * k2 + 1]); pw.y = cvt_pk_bf16(x[8 * k2 + 2], x[8 * k2 + 3]); pw.z = cvt_pk_bf16(x[8 * k2 + 4], x[8 * k2 + 5]); pw.w = cvt_pk_bf16(x[8 * k2 + 6], x[8 * k2 + 7]);
                LAS unsigned char* bp = lds + G_VT + (32 * st + 16 * k2 + 4 * hh + q) * V_STRIDE + (32 * dvt + 16 * g1 + 4 * p) * 2;
                const bf16x8 vb = cat8(tr_read(bp), tr_read(bp + 8 * V_STRIDE));
                o = __builtin_amdgcn_mfma_f32_32x32x16_bf16(__builtin_bit_cast(bf16x8, pw), vb, o, 0, 0, 0); }
        }
        { LAS float* op = (LAS float*)(lds + G_OST + (32 * tt + 4 * hh) * OST_STRIDE) + 32 * dvt + r;
#pragma unroll
          for (int i = 0; i < 16; ++i) op[((i & 3) + 8 * (i >> 2)) * (OST_STRIDE / 4)] = o[i]; }
        LDS_WAIT(); __syncthreads();
        { const int trw = tid >> 3, sg = tid & 7; const LAS f32x4* op = (const LAS f32x4*)(lds + G_OST + trw * OST_STRIDE + sg * 64);
          f32x4 ov[4]; float ssq = 0.f;
#pragma unroll
          for (int i = 0; i < 4; ++i) { ov[i] = op[i]; ssq += (ov[i][0] * ov[i][0] + ov[i][1] * ov[i][1]) + (ov[i][2] * ov[i][2] + ov[i][3] * ov[i][3]); }
          ssq += __shfl_xor(ssq, 1); ssq += __shfl_xor(ssq, 2); ssq += __shfl_xor(ssq, 4);
          const float rs = 1.0f / sqrtf(ssq * (1.0f / DV) + pg8::RMS_EPS);
          const bf16* grow = PROJ + (tok0 + trw) * PS + PC_G + 128 * h + 16 * sg;
          const v4u gw0 = *(const GAS v4u*)(grow), gw1 = *(const GAS v4u*)(grow + 8);
          float gf[16]; { float a8[8]; unpack8(gw0, a8);
#pragma unroll
              for (int j = 0; j < 8; ++j) gf[j] = a8[j];
              unpack8(gw1, a8);
#pragma unroll
              for (int j = 0; j < 8; ++j) gf[8 + j] = a8[j]; }
          float res[16];
#pragma unroll
          for (int i = 0; i < 4; ++i) { const f32x4 gg = *(const GAS f32x4*)(gn + 16 * sg + 4 * i);
#pragma unroll
              for (int j = 0; j < 4; ++j) res[4 * i + j] = ov[i][j] * rs * gg[j] * siluf_(gf[4 * i + j]); }
          bf16* mrow = MIX + (tok0 + trw) * 1024 + 128 * h + 16 * sg;
          { float a8[8];
#pragma unroll
            for (int j = 0; j < 8; ++j) a8[j] = res[j];
            *(GAS v4u*)(mrow) = pack8(a8);
#pragma unroll
            for (int j = 0; j < 8; ++j) a8[j] = res[8 + j];
            *(GAS v4u*)(mrow + 8) = pack8(a8); } }
        { const int c = 128 * h + 8 * (tid & 15), tl = 2 * (tid >> 4);
          float u[4][8];
#pragma unroll
          for (int i = 0; i < 4; ++i) { const int tg = tl - 2 + i;
              if (n == 0 && tg < 0) {
#pragma unroll
                  for (int j = 0; j < 8; ++j) u[i][j] = 0.f;
              } else { const bf16* rp = PROJ + (size_t)((long)tok0 + tg) * PS;
                  const v4u a = *(const GAS v4u*)(rp + PC_CC + c), bq = *(const GAS v4u*)(rp + PC_CX + c); float af[8], bf_[8]; unpack8(a, af); unpack8(bq, bf_);
#pragma unroll
                  for (int j = 0; j < 8; ++j) u[i][j] = af[j] * bf_[j]; } }
          float w0[8], w1[8], w2[8];
          { const f32x4 a = *(const GAS f32x4*)(cw + c), b2 = *(const GAS f32x4*)(cw + c + 4); w0[0] = a[0]; w0[1] = a[1]; w0[2] = a[2]; w0[3] = a[3]; w0[4] = b2[0]; w0[5] = b2[1]; w0[6] = b2[2]; w0[7] = b2[3]; }
          { const f32x4 a = *(const GAS f32x4*)(cw + CONVD + c), b2 = *(const GAS f32x4*)(cw + CONVD + c + 4); w1[0] = a[0]; w1[1] = a[1]; w1[2] = a[2]; w1[3] = a[3]; w1[4] = b2[0]; w1[5] = b2[1]; w1[6] = b2[2]; w1[7] = b2[3]; }
          { const f32x4 a = *(const GAS f32x4*)(cw + 2 * CONVD + c), b2 = *(const GAS f32x4*)(cw + 2 * CONVD + c + 4); w2[0] = a[0]; w2[1] = a[1]; w2[2] = a[2]; w2[3] = a[3]; w2[4] = b2[0]; w2[5] = b2[1]; w2[6] = b2[2]; w2[7] = b2[3]; }
#pragma unroll
          for (int i = 0; i < 2; ++i) { const bf16* rp = PROJ + (tok0 + tl + i) * PS; const v4u cbw = *(const GAS v4u*)(rp + PC_CB + c); float cb[8]; unpack8(cbw, cb);
              float y[8];
#pragma unroll
              for (int j = 0; j < 8; ++j) y[j] = cb[j] * (w0[j] * u[i][j] + w1[j] * u[i + 1][j] + w2[j] * u[i + 2][j]);
              *(GAS v4u*)(MIX + (tok0 + tl + i) * 1024 + 512 + c) = pack8(y); } }
        __syncthreads();
    }
}

__device__ __forceinline__ void final_norm(Frame& F, const float* ssq) {
    const int gw = blockIdx.x * NWAVES + F.wave, NGW = F.G * NWAVES;
    f32x4 gv[4];
#pragma unroll
    for (int j = 0; j < 4; ++j) gv[j] = *((const GAS f32x4*)(F.ap->in[15]) + F.lane + 64 * j);
    for (int m = gw; m < M; m += NGW) {
        const float rs = pg8::rstd_from(ssq, m);
        GAS f32x4* xr = (GAS f32x4*)(F.out + (size_t)m * DM) + F.lane;
#pragma unroll
        for (int j = 0; j < 4; ++j) { const f32x4 v = xr[64 * j]; xr[64 * j] = v * rs * gv[j]; }
    }
}

#ifndef PH_MASK
#define PH_MASK 4095
#endif
__global__ void __launch_bounds__(NWAVES * 64, 2) mega_fwd(Args args) {
    extern __shared__ __attribute__((aligned(16))) unsigned char lds[];
    Frame F;
    F.lds = (LAS unsigned char*)lds;
    F.tid = threadIdx.x; F.lane = F.tid & 63; F.wave = __builtin_amdgcn_readfirstlane(F.tid >> 6);
    F.G = gridDim.x;
    F.ws = args.ws; F.out = args.out; F.ctl = (gu32*)(args.ws + WS_CTL);
    F.ap = (const Args*)__builtin_amdgcn_kernarg_segment_ptr();
    for (int u = F.tid; u < (LDS_BYTES - LDSCTL_OFF) / 4; u += NWAVES * 64) ((LAS unsigned*)(F.lds + LDSCTL_OFF))[u] = 0u;
    __syncthreads();
    const int lo = args.ph_lo, hi = args.ph_hi;
    XcdBarrier bar; bar.bar = (unsigned*)(F.ctl + CW_BAR); bar.x = 0; bar.st = (volatile LAS unsigned*)(F.lds + MISC_OFF + 32);
    if (hi - lo > 1) bar = xcd_barrier_post((unsigned*)(F.ctl + CW_BAR), (volatile LAS unsigned*)(F.lds + MISC_OFF + 32));

    PG8_LAS float* escr = (PG8_LAS float*)(F.lds + EPI_SCR_OFF);

    for (int ph = lo; ph < hi; ++ph) {
        { int t_ = threadIdx.x; asm volatile("" : "+v"(t_)); F.tid = t_; F.lane = t_ & 63; F.wave = __builtin_amdgcn_readfirstlane(t_ >> 6);
          const Args* a_ = (const Args*)__builtin_amdgcn_kernarg_segment_ptr(); asm volatile("" : "+s"(a_)); F.ap = a_;
          unsigned char* w_ = args.ws; asm volatile("" : "+s"(w_)); F.ws = w_; float* o_ = args.out; asm volatile("" : "+s"(o_)); F.out = o_; }
        bf16* HB = (bf16*)(F.ws + WS_HB); bf16* PROJ = (bf16*)(F.ws + WS_PROJ); bf16* MIX = (bf16*)(F.ws + WS_U); bf16* PB = (bf16*)(F.ws + WS_PB);
        float* SSQ[2] = {(float*)(F.ws + WS_SSQ0), (float*)(F.ws + WS_SSQ1)};
        if (ph == 0) { if (PH_MASK & 1) p0_prologue(F); }
        else if (ph == N_PHASES - 1) { if (PH_MASK & 2) final_norm(F, SSQ[0]); }
        else {
            const int L = (ph - 1) >> 3, s = (ph - 1) & 7;
            float* sA = SSQ[L & 1]; float* sB = SSQ[(L & 1) ^ 1];
            if (s == 0) { if (PH_MASK & 4) {
                pg8::Gemm g{HB, w_ptr(F, L, WO_IN), M, PS, 1024}; pg8::StaticOrder S; S.init(M, PS, F.G, (int)blockIdx.x);
                pg8::EpiProj E{PROJ, PS, sA, F.ap->in[5] + L * 256, 12};
                pg8::gemm_phase<pg8::EpiProj, pg8::StaticOrder, true, true>(F.lds + RING_OFF, g, S, E, F.tid); }
            } else if (s == 1) { if (PH_MASK & 8) gla_p1(F, L); }
            else if (s == 2) { if (PH_MASK & 16) gla_p2(F); }
            else if (s == 3) { if (PH_MASK & 32) gla_p3(F, L); }
            else if (s == 4) { if (PH_MASK & 64) {
                pg8::Gemm g{MIX, w_ptr(F, L, WO_OUT), M, 1024, 1024}; pg8::StaticOrder S; S.init(M, 1024, F.G, (int)blockIdx.x);
                pg8::EpiRes<0> E{L == 0 ? F.ap->in[0] : (const float*)F.out, F.out, HB, sB, nullptr, nullptr, escr, F.tid};
                pg8::gemm_phase<pg8::EpiRes<0>, pg8::StaticOrder, true, true>(F.lds + RING_OFF, g, S, E, F.tid); }
            } else if (s == 5) { if (PH_MASK & 128) {
                pg8::Gemm g{HB, w_ptr(F, L, WO_GU), M, 2 * FFN, 1024}; pg8::StaticOrder S; S.init(M, 2 * FFN, F.G, (int)blockIdx.x);
                pg8::EpiSwiGLU E{PROJ, FFN, sB};
                pg8::gemm_phase<pg8::EpiSwiGLU, pg8::StaticOrder, true, true>(F.lds + RING_OFF, g, S, E, F.tid); }
            } else if (s == 6) { if (PH_MASK & 256) {
                pg8::Gemm g{PROJ, w_ptr(F, L, WO_DN), M, 1024, FFN}; pg8::StaticOrder S; S.init(M, 1024, F.G, (int)blockIdx.x);
                pg8::EpiRes<0> E{F.out, F.out, HB, sA, nullptr, nullptr, escr, F.tid};
                pg8::gemm_phase<pg8::EpiRes<0>, pg8::StaticOrder, true, true>(F.lds + RING_OFF, g, S, E, F.tid); }
            } else { if (PH_MASK & 512) {
                if (PH_MASK & 1024) { int kp_ = PLE; asm volatile("" : "+s"(kp_)); pg8::Gemm g{PB + (size_t)L * M * PLE, w_ptr(F, L, WO_PP), M, 1024, kp_}; pg8::StaticOrder S; S.init(M, 1024, F.G, (int)blockIdx.x);
                  pg8::EpiPP E{PROJ, 1024};
                  pg8::gemm_phase<pg8::EpiPP, pg8::StaticOrder, true, true>(F.lds + RING_OFF, g, S, E, F.tid); }
                { int t_ = F.tid; asm volatile("" : "+v"(t_)); F.tid = t_; const Args* a_ = F.ap; asm volatile("" : "+s"(a_)); F.ap = a_; }
                if (PH_MASK & 2048) { pg8::Gemm g{HB, w_ptr(F, L, WO_PG), M, 1024, 1024}; pg8::StaticOrder S; S.init(M, 1024, F.G, (int)blockIdx.x);
                  pg8::EpiRes<1> E{F.out, F.out, (L == DEPTH - 1) ? (bf16*)nullptr : HB, sB, sA, PROJ, escr, F.tid};
                  pg8::gemm_phase<pg8::EpiRes<1>, pg8::StaticOrder, true, true>(F.lds + RING_OFF, g, S, E, F.tid); } }
            }
        }
        if (ph + 1 < hi) xcd_barrier(bar);
    }
}

#ifndef MK_ONE_LAUNCH
#define MK_ONE_LAUNCH 1
#endif
extern "C" void kernel_launch(void* const* d_in, const int* in_sizes, int n_in, void* d_out, int out_size, void* d_ws, size_t ws_size, hipStream_t stream) {
    static int grid = 0;
    if (grid == 0) {
        if (n_in != 16 || in_sizes[0] != M * DM || out_size != M * DM || ws_size < WS_END) { fprintf(stderr, "kernel_launch: unexpected shapes / workspace (%d inputs, in0 %d, out %d, ws %zu)\n", n_in, n_in > 0 ? in_sizes[0] : -1, out_size, ws_size); grid = -1; return; }
        int dev = 0, cus = 0, per_cu = 0;
        if (hipGetDevice(&dev) != hipSuccess || hipDeviceGetAttribute(&cus, hipDeviceAttributeMultiprocessorCount, dev) != hipSuccess) { grid = -1; return; }
        if (hipFuncSetAttribute((const void*)mega_fwd, hipFuncAttributeMaxDynamicSharedMemorySize, LDS_BYTES) != hipSuccess) { fprintf(stderr, "kernel_launch: hipFuncSetAttribute failed\n"); grid = -1; return; }
        if (hipOccupancyMaxActiveBlocksPerMultiprocessor(&per_cu, (const void*)mega_fwd, NWAVES * 64, LDS_BYTES) != hipSuccess || per_cu < 1) { fprintf(stderr, "kernel_launch: occupancy query says %d blocks per CU\n", per_cu); (void)hipGetLastError(); grid = -1; return; }
        grid = cus;
    }
    if (grid < 0) return;
    (void)hipMemsetAsync((char*)d_ws + WS_CTL, 0, CTL_ZERO_BYTES, stream);
    Args a{};
    for (int i = 0; i < 16; ++i) a.in[i] = (const float*)d_in[i];
    a.out = (float*)d_out; a.ws = (unsigned char*)d_ws;
#if MK_ONE_LAUNCH
    a.ph_lo = 0; a.ph_hi = N_PHASES;
    void* kargs[] = {&a};
    hipError_t e = hipLaunchCooperativeKernel((const void*)mega_fwd, dim3(grid), dim3(NWAVES * 64), kargs, LDS_BYTES, stream);
    if (e != hipSuccess) fprintf(stderr, "kernel_launch: cooperative launch failed: %s (grid %d)\n", hipGetErrorString(e), grid);
#else
    for (int ph = 0; ph < N_PHASES; ++ph) { a.ph_lo = ph; a.ph_hi = ph + 1; hipLaunchKernelGGL(mega_fwd, dim3(grid), dim3(NWAVES * 64), LDS_BYTES, stream, a); }
#endif
}
```

```cpp
#include <hip/hip_runtime.h>
#include <cstdio>
#include <cstdint>
namespace pg8 {
#define PG8_LAS __attribute__((address_space(3)))
typedef unsigned short bf16_t;
typedef short bf16x8 __attribute__((ext_vector_type(8)));
typedef float f32x4 __attribute__((ext_vector_type(4)));
typedef unsigned u32x4 __attribute__((ext_vector_type(4)));
constexpr int BM = 256, BK = 64, HALF = 128, HTB = HALF * BK * 2  , STAGE_BYTES = 8 * HTB, NXCD = 8, WGM = 8;

__host__ __device__ __forceinline__ int lds_byte(int r, int c) { const int st = (r >> 4) * 2 + (c >> 5), rr = r & 15, cc = c & 31, ob = rr * 64 + cc * 2; return st * 1024 + (ob ^ (((ob >> 9) & 1) << 5)); }
__host__ __device__ __forceinline__ void stage_rc(int b, int& R, int& C) { const int st = b / 1024, sb = b % 1024, swz = sb ^ (((sb >> 9) & 1) << 5); R = (st >> 1) * 16 + swz / 64; C = (st & 1) * 32 + (swz % 64) / 2; }
__host__ __device__ __forceinline__ int perm32(int rho) { const int n = rho >> 4, i = rho & 15; return 8 * (i >> 2) + 4 * n + (i & 3); }

struct Unit { int pm, pn; };
struct Gemm { const bf16_t* A; const bf16_t* Bt; int M, N, K; };

struct StaticOrder {
    int nM, nN, nwg, G, c;
    __host__ __device__ void init(int M, int N, int G_, int c_) { nM = M / BM; nN = N / BM; nwg = nM * nN; G = G_; c = c_; }
    __host__ __device__ bool next(int i, Unit& u) const {
        const long L = (long)i * G + c; if (L >= nwg) return false;
        int wgid = (int)L; { const int q = nwg / NXCD, r = nwg % NXCD, xcd = wgid % NXCD, off = wgid / NXCD; wgid = (xcd < r ? xcd * (q + 1) : r * (q + 1) + (xcd - r) * q) + off; }
        const int nig = WGM * nN, gid = wgid / nig, fm = gid * WGM, gsz = (nM - fm) < WGM ? (nM - fm) : WGM;
        u.pm = fm + ((wgid % nig) % gsz); u.pn = (wgid % nig) / gsz; return true;
    }
    __device__ __forceinline__ void a_ready(const Unit&) const {}
    __device__ __forceinline__ void done(const Unit&) const {}
};


typedef float f32x2_cv __attribute__((ext_vector_type(2))); typedef __bf16 bf16x2_cv __attribute__((ext_vector_type(2)));
__device__ __forceinline__ unsigned cvt_pk_bf16(float lo, float hi) { const f32x2_cv v = {lo, hi}; const bf16x2_cv b = __builtin_convertvector(v, bf16x2_cv); return __builtin_bit_cast(unsigned, b); }
typedef unsigned u32x2 __attribute__((ext_vector_type(2)));
#define PG8_GAS __attribute__((address_space(1)))
constexpr float RMS_EPS = 1e-6f;
__device__ __forceinline__ float fast_rcp(float x) { return __builtin_amdgcn_rcpf(x); }
__device__ __forceinline__ float fast_exp(float x) { return __builtin_amdgcn_exp2f(x * 1.4426950408889634f); }
__device__ __forceinline__ float fast_log(float x) { return __builtin_amdgcn_logf(x) * 0.6931471805599453f; }
__device__ __forceinline__ float sigmoidf_(float x) { return fast_rcp(1.0f + fast_exp(-x)); }
__device__ __forceinline__ float siluf_(float x) { return x * sigmoidf_(x); }
__device__ __forceinline__ float logsig16(float x) { return (fminf(x, 0.f) - fast_log(1.0f + fast_exp(-fabsf(x)))) * 0.0625f; }
__device__ __forceinline__ float rstd_from(const PG8_GAS float* ssq, int row) { const f32x4 s = *(const PG8_GAS f32x4*)(ssq + (size_t)row * 4); return __builtin_amdgcn_rsqf(((s[0] + s[1]) + (s[2] + s[3])) * (1.0f / 1024.0f) + RMS_EPS); }

struct EpiProj {
    static constexpr bool PERM = true, AFTER_DRAIN = false;
    PG8_GAS bf16_t* O; int ldc; const PG8_GAS float* ssq; const PG8_GAS float* bgate;
    __device__ __forceinline__ void operator()(const f32x4 (&acc)[2][2][4][2], const Unit& u, int wr, int wc, int fr, int fq) const {
        const int row0 = u.pm * BM + wr * 64 + fr;
        const int kind = (u.pn == 12) ? 2 : (u.pn >= 8 ? 1 : 0);
        if (kind == 1) {
            const int col0 = 2048 + (u.pn - 8) * HALF + wc * 32 + 8 * fq;
#pragma unroll
            for (int ai = 0; ai < 2; ++ai)
#pragma unroll
                for (int m = 0; m < 4; ++m) { const int row = row0 + ai * HALF + m * 16; const float rs = rstd_from(ssq, row), rs2 = rs * rs;
                    const f32x4 h0 = acc[ai][0][m][0] * acc[ai][1][m][0] * rs2, h1 = acc[ai][0][m][1] * acc[ai][1][m][1] * rs2;
                    u32x4 w; w.x = cvt_pk_bf16(h0[0], h0[1]); w.y = cvt_pk_bf16(h0[2], h0[3]); w.z = cvt_pk_bf16(h1[0], h1[1]); w.w = cvt_pk_bf16(h1[2], h1[3]);
                    *(PG8_GAS u32x4*)(O + (size_t)row * ldc + col0) = w; }
            return;
        }
        const bool isg = (kind == 2);
        const int col0 = (isg ? 2560 : u.pn * BM) + wc * 32 + 8 * fq;
        f32x4 bv[2][2];
#pragma unroll
        for (int bj = 0; bj < 2; ++bj)
#pragma unroll
            for (int n = 0; n < 2; ++n) bv[bj][n] = isg ? *(const PG8_GAS f32x4*)(bgate + wc * 32 + 8 * fq + bj * HALF + 4 * n) : (f32x4){0.f, 0.f, 0.f, 0.f};
#pragma unroll
        for (int ai = 0; ai < 2; ++ai)
#pragma unroll
            for (int m = 0; m < 4; ++m) { const int row = row0 + ai * HALF + m * 16; const float rs = rstd_from(ssq, row); PG8_GAS bf16_t* rowp = O + (size_t)row * ldc + col0;
#pragma unroll
                for (int bj = 0; bj < 2; ++bj) { f32x4 v0 = acc[ai][bj][m][0] * rs, v1 = acc[ai][bj][m][1] * rs;
                    if (isg) { v0 = v0 + bv[bj][0]; v1 = v1 + bv[bj][1];
#pragma unroll
                        for (int i = 0; i < 4; ++i) { v0[i] = logsig16(v0[i]); v1[i] = logsig16(v1[i]); } }
                    u32x4 w; w.x = cvt_pk_bf16(v0[0], v0[1]); w.y = cvt_pk_bf16(v0[2], v0[3]); w.z = cvt_pk_bf16(v1[0], v1[1]); w.w = cvt_pk_bf16(v1[2], v1[3]);
                    *(PG8_GAS u32x4*)(rowp + bj * HALF) = w; } }
    }
};
template <bool NORS = false> struct EpiSwiGLU_ {
    static constexpr bool PERM = true, AFTER_DRAIN = false;
    PG8_GAS bf16_t* O; int ldc; const PG8_GAS float* ssq;
    __device__ __forceinline__ void operator()(const f32x4 (&acc)[2][2][4][2], const Unit& u, int wr, int wc, int fr, int fq) const {
        const int row0 = u.pm * BM + wr * 64 + fr, col0 = u.pn * HALF + wc * 32 + 8 * fq;
#pragma unroll
        for (int ai = 0; ai < 2; ++ai)
#pragma unroll
            for (int m = 0; m < 4; ++m) { const int row = row0 + ai * HALF + m * 16; const float rs = NORS ? 1.0f : rstd_from(ssq, row); const float k1 = rs * -1.4426950408889634f, k2 = rs * rs;
                f32x4 h0, h1;
                { const f32x4 a = acc[ai][0][m][0], b = acc[ai][1][m][0]; const f32x4 num = a * b * k2, ex = a * k1;
#pragma unroll
                  for (int i = 0; i < 4; ++i) h0[i] = num[i] * fast_rcp(1.0f + __builtin_amdgcn_exp2f(ex[i])); }
                { const f32x4 a = acc[ai][0][m][1], b = acc[ai][1][m][1]; const f32x4 num = a * b * k2, ex = a * k1;
#pragma unroll
                  for (int i = 0; i < 4; ++i) h1[i] = num[i] * fast_rcp(1.0f + __builtin_amdgcn_exp2f(ex[i])); }
                u32x4 w; w.x = cvt_pk_bf16(h0[0], h0[1]); w.y = cvt_pk_bf16(h0[2], h0[3]); w.z = cvt_pk_bf16(h1[0], h1[1]); w.w = cvt_pk_bf16(h1[2], h1[3]);
                *(PG8_GAS u32x4*)(O + (size_t)row * ldc + col0) = w; }
    }
};
typedef EpiSwiGLU_<false> EpiSwiGLU;
struct EpiPP {
    static constexpr bool PERM = true, AFTER_DRAIN = false;
    PG8_GAS bf16_t* O; int ldc;
    __device__ __forceinline__ void operator()(const f32x4 (&acc)[2][2][4][2], const Unit& u, int wr, int wc, int fr, int fq) const {
        const int row0 = u.pm * BM + wr * 64 + fr, col0 = u.pn * BM + wc * 32 + 8 * fq;
#pragma unroll
        for (int ai = 0; ai < 2; ++ai)
#pragma unroll
            for (int m = 0; m < 4; ++m) { PG8_GAS bf16_t* rowp = O + (size_t)(row0 + ai * HALF + m * 16) * ldc + col0;
#pragma unroll
                for (int bj = 0; bj < 2; ++bj) { const f32x4 v0 = acc[ai][bj][m][0], v1 = acc[ai][bj][m][1];
                    u32x4 w; w.x = cvt_pk_bf16(v0[0], v0[1]); w.y = cvt_pk_bf16(v0[2], v0[3]); w.z = cvt_pk_bf16(v1[0], v1[1]); w.w = cvt_pk_bf16(v1[2], v1[3]);
                    *(PG8_GAS u32x4*)(rowp + bj * HALF) = w; } }
    }
};
template <int MODE> struct EpiRes {
    static constexpr bool PERM = false, AFTER_DRAIN = false;
    const PG8_GAS float* basef; const PG8_GAS bf16_t* hbin; PG8_GAS bf16_t* hb; PG8_GAS float* ssq_out; const PG8_GAS float* ssq_in; const PG8_GAS bf16_t* pp; PG8_LAS float* scr; int tid;
    __device__ __forceinline__ void operator()(const f32x4 (&acc_)[2][2][4][2], const Unit& u, int wr, int wc, int fr, int fq) const {
        f32x4 (&acc)[2][2][4][2] = const_cast<f32x4 (&)[2][2][4][2]>(acc_);
        const int col0 = u.pn * BM + wc * 32 + 4 * fq;
        if (MODE == 1) {
#pragma unroll
            for (int ai = 0; ai < 2; ++ai)
#pragma unroll
                for (int m = 0; m < 4; ++m) { const int row = u.pm * BM + ai * HALF + wr * 64 + m * 16 + fr; const PG8_GAS bf16_t* pr = pp + (size_t)row * 1024 + col0;
                    const float rs = rstd_from(ssq_in, row);
#pragma unroll
                    for (int bj = 0; bj < 2; ++bj)
#pragma unroll
                        for (int n = 0; n < 2; ++n) { const u32x2 pw = *(const PG8_GAS u32x2*)(pr + bj * HALF + n * 16); f32x4 v = acc[ai][bj][m][n];
                            v[0] = sigmoidf_(v[0] * rs) * __uint_as_float(pw.x << 16); v[1] = sigmoidf_(v[1] * rs) * __uint_as_float(pw.x & 0xffff0000u);
                            v[2] = sigmoidf_(v[2] * rs) * __uint_as_float(pw.y << 16); v[3] = sigmoidf_(v[3] * rs) * __uint_as_float(pw.y & 0xffff0000u); acc[ai][bj][m][n] = v; }
                    asm volatile("" : "+v"(acc[ai][0][m][0]), "+v"(acc[ai][0][m][1]), "+v"(acc[ai][1][m][0]), "+v"(acc[ai][1][m][1]));
                    asm volatile("" ::: "memory"); }
        }
#pragma unroll
        for (int ai = 0; ai < 2; ++ai)
#pragma unroll
            for (int m = 0; m < 4; ++m) { const int rl = ai * HALF + wr * 64 + m * 16 + fr, row = u.pm * BM + rl; const size_t off = (size_t)row * 1024 + col0;
                float part = 0.f;
#pragma unroll
                for (int bj = 0; bj < 2; ++bj)
#pragma unroll
                    for (int n = 0; n < 2; ++n) { const size_t c = off + bj * HALF + n * 16; const f32x4 v = acc[ai][bj][m][n];
                        f32x4 b;
                        if (basef) b = *(const PG8_GAS f32x4*)(basef + c);
                        else { const u32x2 bw = *(const PG8_GAS u32x2*)(hbin + c); b[0] = __uint_as_float(bw.x << 16); b[1] = __uint_as_float(bw.x & 0xffff0000u); b[2] = __uint_as_float(bw.y << 16); b[3] = __uint_as_float(bw.y & 0xffff0000u); }
                        const f32x4 o = b + v;
                        { u32x2 w; w.x = cvt_pk_bf16(o[0], o[1]); w.y = cvt_pk_bf16(o[2], o[3]); *(PG8_GAS u32x2*)(hb + c) = w; }
                        part += (o[0] * o[0] + o[1] * o[1]) + (o[2] * o[2] + o[3] * o[3]); }
                part += __shfl_xor(part, 16); part += __shfl_xor(part, 32);
                if (fq == 0) scr[rl * 4 + wc] = part;
                if (m & 1) asm volatile("" ::: "memory"); }
        asm volatile("s_waitcnt lgkmcnt(0)" ::: "memory"); __builtin_amdgcn_s_barrier(); asm volatile("" ::: "memory");
        { const int t = tid & 255;
          if (t < 128) { const int rl = (t >> 6) * HALF + wr * 64 + (t & 63); const f32x4 p4 = *(const PG8_LAS f32x4*)(scr + rl * 4);
              ssq_out[(size_t)(u.pm * BM + rl) * 4 + u.pn] = (p4[0] + p4[1]) + (p4[2] + p4[3]); } }
        asm volatile("s_waitcnt lgkmcnt(0)" ::: "memory");
    }
};
struct PPOrder {
    int G, c;
    __device__ __forceinline__ bool next(int i, Unit& u) const {
        int idx;
        if (G == 256) { if (c < 128) { if (i >= 1) return false; idx = 384 + c; } else { if (i >= 3) return false; idx = 3 * (c - 128) + i; } }
        else { idx = i * G + c; if (idx >= 512) return false; }
        u.pm = idx >> 2; u.pn = idx & 3; return true;
    }
    __device__ __forceinline__ void a_ready(const Unit&) const {}
    __device__ __forceinline__ void done(const Unit&) const {}
};
struct EpiNull {
    static constexpr bool PERM = true, AFTER_DRAIN = false;
    __device__ __forceinline__ void operator()(const f32x4 (&acc)[2][2][4][2], const Unit& u, int wr, int wc, int fr, int fq) const {
#pragma unroll
        for (int ai = 0; ai < 2; ++ai)
#pragma unroll
            for (int bj = 0; bj < 2; ++bj)
#pragma unroll
                for (int m = 0; m < 4; ++m)
#pragma unroll
                    for (int n = 0; n < 2; ++n) asm volatile("" :: "v"(acc[ai][bj][m][n]));
    }
};
template <class Epi, class Sched, bool ALIGN_EPI = false, bool SP2 = false>
__device__ __forceinline__ void gemm_phase(PG8_LAS unsigned char* lds, const Gemm g, const Sched& S, const Epi& E, const int tid) {
    const int wid = __builtin_amdgcn_readfirstlane(tid >> 6), lane = tid & 63, wr = wid >> 2, wc = wid & 3, fr = lane & 15, fq = lane >> 4;
    const int K = g.K, nt = K / BK;
    unsigned voffA[2], voffB[2];
#pragma unroll
    for (int i = 0; i < 2; ++i) { int R, C; stage_rc(tid * 16 + i * 8192, R, C); const int Rb = Epi::PERM ? ((R & ~31) + perm32(R & 31)) : R;
        voffA[i] = (unsigned)(R * K + C) * 2u; voffB[i] = (unsigned)(Rb * K + C) * 2u; }
    const size_t kstep = (size_t)(BK * 2);
    const size_t hstep = (size_t)HALF * K * 2;
    const size_t tstep = 2 * hstep;
    const unsigned ldsw = (unsigned)wid * 1024u;
    const int aoff = lds_byte(wr * 64 + fr, fq * 8), boff = lds_byte(wc * 32 + fr, fq * 8);
#define PG8_SA(b, h) (((b) * 2 + (h)) * HTB)
#define PG8_SB(b, h) ((4 + (b) * 2 + (h)) * HTB)
#define PG8_STAGE(bufoff, gbase, voff) do { _Pragma("unroll") for (int _i = 0; _i < 2; ++_i) \
        __builtin_amdgcn_global_load_lds((const unsigned*)((const char*)(gbase) + (voff)[_i]), (PG8_LAS unsigned*)(lds + (bufoff) + ldsw + _i * 8192), 16, 0, 0); } while (0)
#define PG8_LDA(dst, b, h) do { _Pragma("unroll") for (int m = 0; m < 4; ++m) _Pragma("unroll") for (int k = 0; k < 2; ++k) dst[m][k] = *(const PG8_LAS bf16x8*)(lds + PG8_SA(b, h) + aoff + m * 2048 + k * 1024); } while (0)
#define PG8_LDB(dst, b, h) do { _Pragma("unroll") for (int n = 0; n < 2; ++n) _Pragma("unroll") for (int k = 0; k < 2; ++k) dst[n][k] = *(const PG8_LAS bf16x8*)(lds + PG8_SB(b, h) + boff + n * 2048 + k * 1024); } while (0)
#define PG8_MMA(ai, bj, At, Bt) do { __builtin_amdgcn_s_setprio(1); _Pragma("unroll") for (int m = 0; m < 4; ++m) _Pragma("unroll") for (int n = 0; n < 2; ++n) _Pragma("unroll") for (int k = 0; k < 2; ++k) \
        acc[ai][bj][m][n] = __builtin_amdgcn_mfma_f32_16x16x32_bf16(Bt[n][k], At[m][k], acc[ai][bj][m][n], 0, 0, 0); __builtin_amdgcn_s_setprio(0); } while (0)
#define PG8_WAIT_V(n) asm volatile("s_waitcnt vmcnt(" #n ")" ::: "memory")
#define PG8_WAIT_L(n) asm volatile("s_waitcnt lgkmcnt(" #n ")" ::: "memory")
#define PG8_BAR __builtin_amdgcn_s_barrier()
#define PG8_SCHED __builtin_amdgcn_sched_barrier(0)
    Unit cur, nxt; int ui = 0;
    if (!S.next(0, cur)) return;
    f32x4 acc[2][2][4][2];
#pragma unroll
    for (int a = 0; a < 2; ++a)
#pragma unroll
        for (int b = 0; b < 2; ++b)
#pragma unroll
            for (int m = 0; m < 4; ++m)
#pragma unroll
                for (int n = 0; n < 2; ++n) acc[a][b][m][n] = (f32x4){0.f, 0.f, 0.f, 0.f};
    bf16x8 At[4][2], B0[2][2], B1[2][2];
    const char* cA = (const char*)g.A + (size_t)cur.pm * tstep; const char* cB = (const char*)g.Bt + (size_t)cur.pn * tstep;
    S.a_ready(cur);
    if constexpr (SP2) {
        PG8_STAGE(PG8_SB(0, 0), cB, voffB); PG8_STAGE(PG8_SB(0, 1), cB + hstep, voffB); PG8_STAGE(PG8_SA(0, 0), cA, voffA); PG8_STAGE(PG8_SA(0, 1), cA + hstep, voffA);
        if (wr == 1) PG8_BAR;
        PG8_WAIT_V(2); PG8_BAR;
        PG8_STAGE(PG8_SB(1, 0), cB + kstep, voffB); PG8_STAGE(PG8_SA(1, 0), cA + kstep, voffA); PG8_STAGE(PG8_SB(1, 1), cB + hstep + kstep, voffB);
        PG8_WAIT_V(6); PG8_BAR;
    } else {
        PG8_STAGE(PG8_SB(0, 0), cB, voffB); PG8_STAGE(PG8_SA(0, 0), cA, voffA); PG8_STAGE(PG8_SB(0, 1), cB + hstep, voffB); PG8_STAGE(PG8_SA(0, 1), cA + hstep, voffA);
        if (wr == 1) PG8_BAR;
        PG8_WAIT_V(4); PG8_BAR;
        PG8_STAGE(PG8_SB(1, 0), cB + kstep, voffB); PG8_STAGE(PG8_SA(1, 0), cA + kstep, voffA); PG8_STAGE(PG8_SB(1, 1), cB + hstep + kstep, voffB);
        PG8_WAIT_V(6); PG8_BAR;
    }
    for (;;) {
        const bool has_next = S.next(ui + 1, nxt);
        const char* nA = has_next ? (const char*)g.A + (size_t)nxt.pm * tstep : cA; const char* nB = has_next ? (const char*)g.Bt + (size_t)nxt.pn * tstep : cB;
        for (int t = 0; t < nt; t += 2) {
            const bool last = (t == nt - 2);
            const char* a1 = cA + (size_t)(t + 1) * kstep;
            const char* a2 = last ? nA : cA + (size_t)(t + 2) * kstep; const char* b2 = last ? nB : cB + (size_t)(t + 2) * kstep;
            const char* a3 = a2 + kstep; const char* b3 = b2 + kstep;
            if (last && has_next) S.a_ready(nxt);
            if constexpr (SP2) {
            PG8_LDB(B0, 0, 0); PG8_LDB(B1, 0, 1); PG8_SCHED; PG8_LDA(At, 0, 0); PG8_STAGE(PG8_SA(1, 1), a1 + hstep, voffA);
            PG8_WAIT_V(8); PG8_WAIT_L(0); PG8_BAR; PG8_MMA(0, 0, At, B0); PG8_MMA(0, 1, At, B1); PG8_BAR; PG8_SCHED;
            PG8_LDA(At, 0, 1); PG8_STAGE(PG8_SB(0, 0), b2, voffB); PG8_STAGE(PG8_SB(0, 1), b2 + hstep, voffB); PG8_STAGE(PG8_SA(0, 0), a2, voffA);
            PG8_WAIT_V(8); PG8_WAIT_L(0); PG8_BAR; PG8_MMA(1, 0, At, B0); PG8_MMA(1, 1, At, B1); PG8_BAR; PG8_SCHED;
            PG8_LDB(B0, 1, 0); PG8_LDB(B1, 1, 1); PG8_SCHED; PG8_LDA(At, 1, 0); PG8_STAGE(PG8_SA(0, 1), a2 + hstep, voffA);
            PG8_WAIT_V(8); PG8_WAIT_L(0); PG8_BAR; PG8_MMA(0, 0, At, B0); PG8_MMA(0, 1, At, B1); PG8_BAR; PG8_SCHED;
            PG8_LDA(At, 1, 1); PG8_STAGE(PG8_SB(1, 0), b3, voffB); PG8_STAGE(PG8_SB(1, 1), b3 + hstep, voffB); PG8_STAGE(PG8_SA(1, 0), a3, voffA);
            PG8_WAIT_V(8); PG8_WAIT_L(0); PG8_BAR; PG8_MMA(1, 0, At, B0); PG8_MMA(1, 1, At, B1); PG8_BAR; PG8_SCHED;
            } else {
            PG8_LDB(B0, 0, 0); PG8_SCHED; PG8_LDA(At, 0, 0); PG8_STAGE(PG8_SA(1, 1), a1 + hstep, voffA);
            PG8_WAIT_L(8); PG8_BAR; PG8_WAIT_L(0); PG8_MMA(0, 0, At, B0); PG8_BAR; PG8_SCHED;
            PG8_LDB(B1, 0, 1); PG8_STAGE(PG8_SB(0, 0), b2, voffB);
            PG8_BAR; PG8_WAIT_L(0); PG8_MMA(0, 1, At, B1); PG8_BAR;
            PG8_LDA(At, 0, 1); PG8_STAGE(PG8_SA(0, 0), a2, voffA);
            PG8_BAR; PG8_WAIT_L(0); PG8_MMA(1, 0, At, B0); PG8_BAR; PG8_SCHED;
            PG8_STAGE(PG8_SB(0, 1), b2 + hstep, voffB);
            PG8_WAIT_V(6); PG8_BAR; PG8_MMA(1, 1, At, B1); PG8_BAR;
            PG8_LDB(B0, 1, 0); PG8_SCHED; PG8_LDA(At, 1, 0); PG8_STAGE(PG8_SA(0, 1), a2 + hstep, voffA);
            PG8_WAIT_L(8); PG8_BAR; PG8_WAIT_L(0); PG8_MMA(0, 0, At, B0); PG8_BAR; PG8_SCHED;
            PG8_LDB(B1, 1, 1); PG8_STAGE(PG8_SB(1, 0), b3, voffB);
            PG8_BAR; PG8_WAIT_L(0); PG8_MMA(0, 1, At, B1); PG8_BAR;
            PG8_LDA(At, 1, 1); PG8_STAGE(PG8_SA(1, 0), a3, voffA);
            PG8_BAR; PG8_WAIT_L(0); PG8_MMA(1, 0, At, B0); PG8_BAR; PG8_SCHED;
            PG8_STAGE(PG8_SB(1, 1), b3 + hstep, voffB);
            PG8_WAIT_V(6); PG8_BAR; PG8_MMA(1, 1, At, B1); PG8_BAR;
            }
        }
        if constexpr (ALIGN_EPI) { if (wr == 0) PG8_BAR; }
        if constexpr (!Epi::AFTER_DRAIN) { E(acc, cur, wr, wc, fr, fq); S.done(cur); }
        if (!has_next) break;
#pragma unroll
        for (int a = 0; a < 2; ++a)
#pragma unroll
            for (int b = 0; b < 2; ++b)
#pragma unroll
                for (int m = 0; m < 4; ++m)
#pragma unroll
                    for (int n = 0; n < 2; ++n) acc[a][b][m][n] = (f32x4){0.f, 0.f, 0.f, 0.f};
        cur = nxt; cA = nA; cB = nB; ++ui;
        if constexpr (ALIGN_EPI) { if (wr == 1) PG8_BAR; }
    }
    PG8_WAIT_V(0);
    if constexpr (!ALIGN_EPI) { if (wr == 0) PG8_BAR; }
    PG8_BAR;
    if constexpr (Epi::AFTER_DRAIN) { E.fused(acc, cur, wr, wc, fr, fq, lds, wid, lane); S.done(cur); }
#undef PG8_SA
#undef PG8_SB
#undef PG8_STAGE
#undef PG8_LDA
#undef PG8_LDB
#undef PG8_MMA
#undef PG8_WAIT_V
#undef PG8_WAIT_L
#undef PG8_BAR
#undef PG8_SCHED
}
}

constexpr int NWAVES = 8;
constexpr int BATCH = 4, SEQ = 8192, DM = 1024, DEPTH = 2, M = BATCH * SEQ;
constexpr int NH = 4, DK = 64, DV = 128, CHUNK = 64, NCH = SEQ / CHUNK;
constexpr int NITEM = BATCH * NH * NCH;
constexpr int IN_DIM = 3088, FFN = 2816, PLE = 256, CONVD = 512;
constexpr int NPROJ = 3328;
constexpr int PS = 2816;
constexpr int PC_Q = 0, PC_K = 256, PC_V = 512, PC_G = 1024, PC_CB = 1536, PC_U = 2048, PC_LA = 2560;
constexpr int N_PHASES = 18;

constexpr size_t MiB = 1u << 20;
constexpr size_t WS_CTL = 0, CTL_ZERO_BYTES = 1 * MiB;
constexpr size_t WS_SSQ0 = 1 * MiB, WS_SSQ1 = 1 * MiB + 512 * 1024;
constexpr size_t WS_DECAY = 2 * MiB;
constexpr size_t WS_W = 4 * MiB, W_LAYER = 28 * MiB;
constexpr size_t WO_IN = 0, WO_OUT = 6815744, WO_GU = WO_OUT + 2 * MiB, WO_DN = WO_GU + 11 * MiB, WO_PG = WO_DN + 5767168, WO_PP = WO_PG + 2 * MiB;
static_assert(WO_PP + 512 * 1024 <= W_LAYER, "weights per layer");
constexpr size_t WS_HB = 64 * MiB;
constexpr size_t WS_PROJ = 128 * MiB;
constexpr size_t WS_U = 336 * MiB;
constexpr size_t WS_S = 400 * MiB;
constexpr size_t WS_PB = 432 * MiB;
constexpr size_t WS_UB = 464 * MiB;
constexpr size_t WS_END = 496 * MiB;
constexpr int CW_BAR = 4096;

constexpr int RING_OFF = 0, RING_BYTES = 131072;
constexpr int EPI_SCR_OFF = RING_BYTES;
constexpr int LDSCTL_OFF = RING_BYTES + 4096, MISC_OFF = LDSCTL_OFF + 320;
constexpr int LDS_BYTES = 147456;
constexpr int G_TOT = 0, G_QT = 2048, G_KT = 12288, G_VT = 24576, G_ST = 45056, G_OST = 65536, G_UT = 45056;
constexpr int QK_STRIDE = 144, KD_STRIDE = 192, V_STRIDE = 320, OST_STRIDE = 528, U_STRIDE = 272;

#define GAS __attribute__((address_space(1)))
#define LAS __attribute__((address_space(3)))
typedef unsigned short bf16;
typedef unsigned v4u __attribute__((ext_vector_type(4)));
typedef unsigned v2u __attribute__((ext_vector_type(2)));
typedef float f32x4 __attribute__((ext_vector_type(4)));
typedef float f32x16 __attribute__((ext_vector_type(16)));
typedef short bf16x8 __attribute__((ext_vector_type(8)));
typedef short s16x4 __attribute__((ext_vector_type(4)));
typedef GAS unsigned gu32;
#define RLX_AGENT __ATOMIC_RELAXED, __HIP_MEMORY_SCOPE_AGENT
#define LDS_WAIT() asm volatile("s_waitcnt lgkmcnt(0)" ::: "memory")
#define VM_WAIT() asm volatile("s_waitcnt vmcnt(0)" ::: "memory")
using pg8::cvt_pk_bf16; using pg8::fast_exp; using pg8::fast_rcp; using pg8::siluf_;
__device__ __forceinline__ float bf_lo(unsigned w) { return __uint_as_float(w << 16); }
__device__ __forceinline__ float bf_hi(unsigned w) { return __uint_as_float(w & 0xffff0000u); }
__device__ __forceinline__ void unpack8(const v4u& w, float (&f)[8]) { f[0] = bf_lo(w.x); f[1] = bf_hi(w.x); f[2] = bf_lo(w.y); f[3] = bf_hi(w.y); f[4] = bf_lo(w.z); f[5] = bf_hi(w.z); f[6] = bf_lo(w.w); f[7] = bf_hi(w.w); }
__device__ __forceinline__ v4u pack8(const float (&f)[8]) { v4u w; w.x = cvt_pk_bf16(f[0], f[1]); w.y = cvt_pk_bf16(f[2], f[3]); w.z = cvt_pk_bf16(f[4], f[5]); w.w = cvt_pk_bf16(f[6], f[7]); return w; }
#define XB_TMO      128
#define XB_XCNT(j)  (256  + 64 * (j))
#define XB_XSUB(j)  (1280 + 64 * (j))
#define XB_XGEN(j)  (2304 + 64 * (j))
#define XB_TOP      3328
#define XB_TOPGEN   3392
#define XCD_BAR_WORDS 3456
#define XB_SPIN_CAP (1u << 18)

__device__ __forceinline__ unsigned xb_ld(unsigned* p)              { return __hip_atomic_load(p, __ATOMIC_RELAXED, __HIP_MEMORY_SCOPE_AGENT); }
__device__ __forceinline__ unsigned xb_add(unsigned* p, unsigned v) { return __hip_atomic_fetch_add(p, v, __ATOMIC_RELAXED, __HIP_MEMORY_SCOPE_AGENT); }
__device__ __forceinline__ unsigned xb_xcc_id() { return (unsigned)__builtin_amdgcn_s_getreg((3 << 11) | 20) & 0xFu; }
#define XB_SPIN(cond, bar) do { unsigned _sp = 0; while (cond) { __builtin_amdgcn_s_sleep(1); \
    if ((++_sp & 255u) == 0u) { if (xb_ld(&(bar)[XB_TMO])) break; if (_sp > XB_SPIN_CAP) { atomicAdd(&(bar)[XB_TMO], 1u); break; } } } } while (0)

struct XcdBarrier {
    unsigned* bar; unsigned x;
    volatile LAS unsigned* st;
};

__device__ __forceinline__ XcdBarrier xcd_barrier_post(unsigned* bar, volatile LAS unsigned* st) {
    XcdBarrier b; b.bar = bar; b.x = xb_xcc_id(); b.st = st;
    if (threadIdx.x == 0) (void)xb_add(&bar[XB_XCNT(b.x)], 1u);
    return b;
}
__device__ __forceinline__ void xcd_barrier_complete(unsigned* bar, unsigned x, unsigned& nloc, unsigned& nx) {
    const unsigned G = gridDim.x * gridDim.y * gridDim.z;
    unsigned sum, cnt, mine, sp = 0u;
    for (;;) {
        sum = 0u; cnt = 0u; mine = 0u;
#pragma unroll
        for (unsigned j = 0; j < 16; ++j) { const unsigned c = xb_ld(&bar[XB_XCNT(j)]); sum += c; cnt += (c > 0u) ? 1u : 0u; mine = (j == x) ? c : mine; }
        if (sum == G) break;
        __builtin_amdgcn_s_sleep(1);
        if ((++sp & 255u) == 0u) { if (xb_ld(&bar[XB_TMO])) break; if (sp > XB_SPIN_CAP) { atomicAdd(&bar[XB_TMO], 1u); break; } }
    }
    nloc = mine > 0u ? mine : 1u; nx = cnt > 0u ? cnt : 1u;
}

__device__ __forceinline__ void xcd_barrier(const XcdBarrier& b) {
    asm volatile("s_waitcnt vmcnt(0)" ::: "memory");
    __syncthreads();
    if (threadIdx.x == 0) {
        unsigned* bar = b.bar;
        __builtin_amdgcn_s_waitcnt(0);
        unsigned nloc = b.st[0], nx = b.st[1];
        if (nloc == 0u) { xcd_barrier_complete(bar, b.x, nloc, nx); b.st[0] = nloc; b.st[1] = nx; }
        const unsigned old = xb_add(&bar[XB_XSUB(b.x)], 1u);
        const unsigned gen = old / nloc;
        if (old + 1u == (gen + 1u) * nloc) {
            __builtin_amdgcn_fence(__ATOMIC_RELEASE, "agent");
            asm volatile("s_waitcnt vmcnt(0)" ::: "memory");
            const unsigned og = xb_add(&bar[XB_TOP], 1u);
            const unsigned tg = og / nx;
            if (og + 1u == (tg + 1u) * nx) xb_add(&bar[XB_TOPGEN], 1u);
            else XB_SPIN(xb_ld(&bar[XB_TOPGEN]) == tg, bar);
            __builtin_amdgcn_fence(__ATOMIC_ACQUIRE, "agent");
            xb_add(&bar[XB_XGEN(b.x)], 1u);
            asm volatile("s_waitcnt vmcnt(0)" ::: "memory");
        } else {
            XB_SPIN(xb_ld(&bar[XB_XGEN(b.x)]) == gen, bar);
            __builtin_amdgcn_fence(__ATOMIC_ACQUIRE, "agent");
            asm volatile("s_waitcnt vmcnt(0)" ::: "memory");
        }
    }
    __syncthreads();
}

struct Args { const float* in[16]; float* out; unsigned char* ws; int ph_lo, ph_hi; };
struct Frame {
    LAS unsigned char* lds;
    gu32* ctl;
    int tid, lane, wave;
    int G;
    const __attribute__((address_space(4))) Args* ap;
    GAS float* out; GAS unsigned char* ws;
};
__device__ __forceinline__ GAS bf16* w_ptr(const Frame& F, int L, size_t off) { return (GAS bf16*)(F.ws + WS_W + (size_t)L * W_LAYER + off); }
__device__ __forceinline__ float wave_sum(float v) {
#pragma unroll
    for (int o = 1; o < 64; o <<= 1) v += __shfl_xor(v, o);
    return v;
}
__device__ __forceinline__ s16x4 tr_read(LAS unsigned char* p) { typedef short v4i16_t __attribute__((ext_vector_type(4))); return __builtin_bit_cast(s16x4, __builtin_amdgcn_ds_read_tr16_b64_v4i16((LAS v4i16_t*)p)); }
__device__ __forceinline__ bf16x8 cat8(s16x4 lo, s16x4 hi) { return (bf16x8){lo[0], lo[1], lo[2], lo[3], hi[0], hi[1], hi[2], hi[3]}; }

struct TDesc { const GAS float* src; const GAS float* gk; GAS bf16* dst; int ldw, K; float cmul; };
constexpr int I_IN = 16 * 96, I_OUT = 16 * 32, I_GU = 16 * 176, I_DN = 44 * 32, I_PG = 16 * 32, I_PP = 4 * 32, I_LAYER = I_IN + I_OUT + I_GU + I_DN + I_PG + I_PP;
__device__ __forceinline__ TDesc tr_decode(const Frame& F, int it) {
    const int L = it / I_LAYER; int r = it % I_LAYER; TDesc d;
    if (r < I_IN) { const int kb = r / 96, nb = r % 96, n0 = 32 * nb, k0 = 64 * kb;
        const int sc = n0 < 1536 ? n0 : (n0 < 2048 ? n0 + 16 : ((((n0 - 2048) >> 7) & 1) ? 2576 : 2064) + 128 * ((n0 - 2048) >> 8) + ((n0 - 2048) & 127));
        d.src = ((const GAS float*)F.ap->in[3]) + (size_t)L * DM * IN_DIM + (size_t)k0 * IN_DIM + sc; d.gk = ((const GAS float*)F.ap->in[2]) + L * DM + k0; d.dst = w_ptr(F, L, WO_IN) + (size_t)n0 * 1024 + k0;
        d.ldw = IN_DIM; d.K = 1024; d.cmul = n0 < 256 ? 0.125f : 1.0f; return d; } r -= I_IN;
    if (r < I_OUT) { const int kb = r / 32, nb = r % 32, k0 = 64 * kb;
        d.src = ((const GAS float*)F.ap->in[8]) + (size_t)L * 1024 * 1024 + (size_t)k0 * 1024 + 32 * nb; d.gk = nullptr; d.dst = w_ptr(F, L, WO_OUT) + (size_t)(32 * nb) * 1024 + k0;
        d.ldw = 1024; d.K = 1024; d.cmul = 1.0f; return d; } r -= I_OUT;
    if (r < I_GU) { const int kb = r / 176, nb = r % 176, n0 = 32 * nb, pn = n0 >> 8, bj = (n0 >> 7) & 1, sc = bj * FFN + 128 * pn + (n0 & 127), k0 = 64 * kb;
        d.src = ((const GAS float*)F.ap->in[10]) + (size_t)L * DM * 2 * FFN + (size_t)k0 * 2 * FFN + sc; d.gk = ((const GAS float*)F.ap->in[9]) + L * DM + k0; d.dst = w_ptr(F, L, WO_GU) + (size_t)n0 * 1024 + k0;
        d.ldw = 2 * FFN; d.K = 1024; d.cmul = 1.0f; return d; } r -= I_GU;
    if (r < I_DN) { const int kb = r / 32, nb = r % 32, k0 = 64 * kb;
        d.src = ((const GAS float*)F.ap->in[11]) + (size_t)L * FFN * DM + (size_t)k0 * DM + 32 * nb; d.gk = nullptr; d.dst = w_ptr(F, L, WO_DN) + (size_t)(32 * nb) * FFN + k0;
        d.ldw = DM; d.K = FFN; d.cmul = 1.0f; return d; } r -= I_DN;
    if (r < I_PG) { const int kb = r / 32, nb = r % 32, k0 = 64 * kb;
        d.src = ((const GAS float*)F.ap->in[13]) + (size_t)L * DM * DM + (size_t)k0 * DM + 32 * nb; d.gk = ((const GAS float*)F.ap->in[12]) + L * DM + k0; d.dst = w_ptr(F, L, WO_PG) + (size_t)(32 * nb) * 1024 + k0;
        d.ldw = DM; d.K = 1024; d.cmul = 1.0f; return d; } r -= I_PG;
    { const int kb = r / 32, nb = r % 32, k0 = 64 * kb;
        d.src = ((const GAS float*)F.ap->in[14]) + (size_t)L * PLE * DM + (size_t)k0 * DM + 32 * nb; d.gk = nullptr; d.dst = w_ptr(F, L, WO_PP) + (size_t)(32 * nb) * PLE + k0;
        d.ldw = DM; d.K = PLE; d.cmul = 1.0f; return d; }
}
struct TRegs { f32x4 v[8]; float g[8]; };
__device__ __forceinline__ void tr_load(const TDesc& d, TRegs& R, int lane) {
#pragma unroll
    for (int j = 0; j < 8; ++j) { const int kk = (lane >> 3) + 8 * j; R.v[j] = *(const GAS f32x4*)(d.src + (size_t)kk * d.ldw + 4 * (lane & 7)); R.g[j] = d.gk ? d.gk[kk] : 1.0f; }
}
__device__ __forceinline__ void tr_process(const TDesc& d, const TRegs& R, LAS float* scr, int lane) {
#pragma unroll
    for (int j = 0; j < 8; ++j) { const int kk = (lane >> 3) + 8 * j; const float s = R.g[j] * d.cmul; LAS float* w = scr + kk * 33 + 4 * (lane & 7);
        w[0] = R.v[j][0] * s; w[1] = R.v[j][1] * s; w[2] = R.v[j][2] * s; w[3] = R.v[j][3] * s; }
    LDS_WAIT(); asm volatile("" ::: "memory");
    const int c = lane & 7;
#pragma unroll
    for (int j = 0; j < 4; ++j) { const int n = (lane >> 3) + 8 * j; const LAS float* s = scr + (8 * c) * 33 + n;
        v4u o; o.x = cvt_pk_bf16(s[0 * 33], s[1 * 33]); o.y = cvt_pk_bf16(s[2 * 33], s[3 * 33]); o.z = cvt_pk_bf16(s[4 * 33], s[5 * 33]); o.w = cvt_pk_bf16(s[6 * 33], s[7 * 33]);
        *(GAS v4u*)(d.dst + (size_t)n * d.K + 8 * c) = o; }
    LDS_WAIT(); asm volatile("" ::: "memory");
}
__device__ __forceinline__ void p0_prologue(Frame& F) {
    LAS float* scr = (LAS float*)(F.lds + RING_OFF + F.wave * 16384);
    const int gw = blockIdx.x * NWAVES + F.wave, NGW = F.G * NWAVES;
    { int it = gw; TDesc d; TRegs R;
      if (it < DEPTH * I_LAYER) { d = tr_decode(F, it); tr_load(d, R, F.lane); }
      while (it < DEPTH * I_LAYER) { const int itn = it + NGW; TDesc dn = d; TRegs Rn = R;
          if (itn < DEPTH * I_LAYER) { dn = tr_decode(F, itn); tr_load(dn, Rn, F.lane); }
          tr_process(d, R, scr, F.lane); d = dn; R = Rn; it = itn; } }
    const int gt = blockIdx.x * (NWAVES * 64) + F.tid, NGT = F.G * NWAVES * 64;
    for (int it = gt; it < DEPTH * 256 * 128; it += NGT) {
        const int L = it >> 15, r = it & 32767, n = r >> 7, k0 = (r & 127) * 8;
        const GAS float* win = ((const GAS float*)F.ap->in[3]) + (size_t)L * DM * IN_DIM; const GAS float* wgu = ((const GAS float*)F.ap->in[4]) + (size_t)L * 16 * 256 + n; const GAS float* g1 = ((const GAS float*)F.ap->in[2]) + L * DM;
        float wg[16];
#pragma unroll
        for (int rr = 0; rr < 16; ++rr) wg[rr] = wgu[rr * 256];
        float o[8];
#pragma unroll
        for (int kk = 0; kk < 8; ++kk) { const GAS f32x4* wr_ = (const GAS f32x4*)(win + (size_t)(k0 + kk) * IN_DIM + 1536); float s = 0.f;
#pragma unroll
            for (int rr = 0; rr < 4; ++rr) { const f32x4 w4 = wr_[rr]; s += (w4[0] * wg[4 * rr] + w4[1] * wg[4 * rr + 1]) + (w4[2] * wg[4 * rr + 2] + w4[3] * wg[4 * rr + 3]); }
            o[kk] = s * g1[k0 + kk]; }
        *(GAS v4u*)(w_ptr(F, L, WO_IN) + (size_t)(3072 + n) * 1024 + k0) = pack8(o);
    }
    GAS bf16* HB = (GAS bf16*)(F.ws + WS_HB); GAS float* SSQ0 = (GAS float*)(F.ws + WS_SSQ0);
    for (int m = 2 * gw; m < M; m += 2 * NGW) {
        f32x4 v[2][4]; float s[2] = {0.f, 0.f};
#pragma unroll
        for (int rr = 0; rr < 2; ++rr) { const GAS f32x4* xr = (const GAS f32x4*)(((const GAS float*)F.ap->in[0]) + (size_t)(m + rr) * DM) + F.lane;
#pragma unroll
            for (int j = 0; j < 4; ++j) v[rr][j] = xr[64 * j]; }
#pragma unroll
        for (int rr = 0; rr < 2; ++rr) {
#pragma unroll
            for (int j = 0; j < 4; ++j) s[rr] += (v[rr][j][0] * v[rr][j][0] + v[rr][j][1] * v[rr][j][1]) + (v[rr][j][2] * v[rr][j][2] + v[rr][j][3] * v[rr][j][3]);
            s[rr] = wave_sum(s[rr]);
            GAS v2u* o8 = (GAS v2u*)(HB + (size_t)(m + rr) * DM) + F.lane;
#pragma unroll
            for (int j = 0; j < 4; ++j) { v2u w; w.x = cvt_pk_bf16(v[rr][j][0], v[rr][j][1]); w.y = cvt_pk_bf16(v[rr][j][2], v[rr][j][3]); o8[64 * j] = w; }
            if (F.lane == 0) *(GAS f32x4*)(SSQ0 + (size_t)(m + rr) * 4) = (f32x4){s[rr], 0.f, 0.f, 0.f}; }
    }
    GAS bf16* PB = (GAS bf16*)(F.ws + WS_PB);
    constexpr size_t NP8 = (size_t)DEPTH * M * PLE / 8;
    for (size_t i = (size_t)gt; i < NP8; i += 4 * (size_t)NGT) {
        f32x4 a[4], b[4];
#pragma unroll
        for (int u = 0; u < 4; ++u) { const size_t ii = i + (size_t)u * NGT; if (ii < NP8) { const GAS f32x4* s = (const GAS f32x4*)(F.ap->in[1]) + 2 * ii; a[u] = s[0]; b[u] = s[1]; } }
#pragma unroll
        for (int u = 0; u < 4; ++u) { const size_t ii = i + (size_t)u * NGT; if (ii < NP8) {
            v4u w; w.x = cvt_pk_bf16(a[u][0], a[u][1]); w.y = cvt_pk_bf16(a[u][2], a[u][3]); w.z = cvt_pk_bf16(b[u][0], b[u][1]); w.w = cvt_pk_bf16(b[u][2], b[u][3]);
            *((GAS v4u*)PB + ii) = w; } }
    }
}

__device__ __forceinline__ void gla_prefix(const v4u& la, LAS unsigned char* lds, int wid, int lane, float (&bc)[8], float (&tot)[8]) {
    float c[8]; unpack8(la, c);
#pragma unroll
    for (int off = 8; off < 64; off <<= 1)
#pragma unroll
        for (int j = 0; j < 8; ++j) { const float v = __shfl_up(c[j], off); if (lane >= off) c[j] += v; }
    LAS float* T = (LAS float*)(lds + G_TOT);
    const int d0 = 8 * (lane & 7);
    if (lane >= 56) { *(LAS f32x4*)(T + wid * 64 + d0) = (f32x4){c[0], c[1], c[2], c[3]}; *(LAS f32x4*)(T + wid * 64 + d0 + 4) = (f32x4){c[4], c[5], c[6], c[7]}; }
    LDS_WAIT(); __syncthreads();
    float off[8];
#pragma unroll
    for (int j = 0; j < 8; ++j) { off[j] = 0.f; tot[j] = 0.f; }
#pragma unroll
    for (int w = 0; w < 8; ++w) { const f32x4 a = *(LAS f32x4*)(T + w * 64 + d0), b = *(LAS f32x4*)(T + w * 64 + d0 + 4);
        const float tv[8] = {a[0], a[1], a[2], a[3], b[0], b[1], b[2], b[3]};
#pragma unroll
        for (int j = 0; j < 8; ++j) { tot[j] += tv[j]; if (w < wid) off[j] += tv[j]; } }
#pragma unroll
    for (int j = 0; j < 8; ++j) bc[j] = off[j] + c[j];
}

struct P1Regs { v4u la, kk, vv[2]; };
__device__ __forceinline__ void p1_load(P1Regs& R, const GAS bf16* PROJ, int item, int t, int d0, int tid) {
    const int bh = item >> 7, n = item & 127, b = bh >> 2, h = bh & 3; const size_t tok0 = (size_t)b * SEQ + (size_t)n * CHUNK;
    const GAS bf16* row = PROJ + (tok0 + t) * PS;
    R.la = *(const GAS v4u*)(row + PC_LA + 64 * h + d0);
    R.kk = *(const GAS v4u*)(row + PC_K + 64 * h + d0);
#pragma unroll
    for (int i = 0; i < 2; ++i) R.vv[i] = *(const GAS v4u*)(PROJ + (tok0 + 32 * i + (tid >> 4)) * PS + PC_V + 128 * h + 8 * (tid & 15));
}
__device__ __forceinline__ void gla_p1(Frame& F, int L) {
    const GAS bf16* PROJ = (const GAS bf16*)(F.ws + WS_PROJ); GAS bf16* U = (GAS bf16*)(F.ws + WS_UB); GAS float* DEC = (GAS float*)(F.ws + WS_DECAY);
    LAS unsigned char* lds = F.lds + RING_OFF; const int wid = F.wave, lane = F.lane, tid = F.tid;
    const int t = 8 * wid + (lane >> 3), d0 = 8 * (lane & 7);
    const int r = lane & 31, hh = lane >> 5, g1 = (lane >> 4) & 1, q = (lane & 15) >> 2, p = lane & 3;
    const int dkt = wid >> 2, dvt = wid & 3;
    P1Regs R;
    if ((int)blockIdx.x < NITEM) p1_load(R, PROJ, blockIdx.x, t, d0, tid);
    for (int item = blockIdx.x; item < NITEM; item += F.G) {
#pragma unroll
        for (int i = 0; i < 2; ++i) *(LAS v4u*)(lds + G_VT + (32 * i + (tid >> 4)) * V_STRIDE + (tid & 15) * 16) = R.vv[i];
        float bc[8], tot[8]; gla_prefix(R.la, lds, wid, lane, bc, tot);
        float kf[8]; unpack8(R.kk, kf);
#pragma unroll
        for (int j = 0; j < 8; ++j) kf[j] *= fast_exp(tot[j] - bc[j]);
        *(LAS v4u*)(lds + G_KT + t * KD_STRIDE + d0 * 2) = pack8(kf);
        if (tid < 8) { GAS f32x4* dp = (GAS f32x4*)(DEC + (size_t)item * 64 + d0); dp[0] = (f32x4){fast_exp(tot[0]), fast_exp(tot[1]), fast_exp(tot[2]), fast_exp(tot[3])}; dp[1] = (f32x4){fast_exp(tot[4]), fast_exp(tot[5]), fast_exp(tot[6]), fast_exp(tot[7])}; }
        if (item + F.G < NITEM) p1_load(R, PROJ, item + F.G, t, d0, tid);
        LDS_WAIT(); __syncthreads();
        f32x16 acc;
#pragma unroll
        for (int i = 0; i < 16; ++i) acc[i] = 0.f;
#pragma unroll
        for (int ks = 0; ks < 4; ++ks) { const int rw = 16 * ks + 8 * hh + q;
            LAS unsigned char* ap = lds + G_KT + rw * KD_STRIDE + (32 * dkt + 16 * g1 + 4 * p) * 2;
            LAS unsigned char* bp = lds + G_VT + rw * V_STRIDE + (32 * dvt + 16 * g1 + 4 * p) * 2;
            const bf16x8 a = cat8(tr_read(ap), tr_read(ap + 4 * KD_STRIDE)), bb = cat8(tr_read(bp), tr_read(bp + 4 * V_STRIDE));
            acc = __builtin_amdgcn_mfma_f32_32x32x16_bf16(a, bb, acc, 0, 0, 0); }
        { LAS unsigned short* up = (LAS unsigned short*)(lds + G_UT + (32 * dkt + 4 * hh) * U_STRIDE) + 32 * dvt + r;
#pragma unroll
          for (int i = 0; i < 16; i += 2) { const unsigned w = cvt_pk_bf16(acc[i], acc[i + 1]);
              up[((i & 3) + 8 * (i >> 2)) * (U_STRIDE / 2)] = (unsigned short)(w & 0xffffu); up[(((i + 1) & 3) + 8 * ((i + 1) >> 2)) * (U_STRIDE / 2)] = (unsigned short)(w >> 16); } }
        LDS_WAIT(); __syncthreads();
        { const int row = tid >> 3, sg = tid & 7; const LAS v4u* sp = (const LAS v4u*)(lds + G_UT + row * U_STRIDE + sg * 32); const v4u a = sp[0], b2 = sp[1];
          GAS v4u* gp = (GAS v4u*)(U + (size_t)item * 8192 + row * 128 + sg * 16); gp[0] = a; gp[1] = b2; }
    }
}

__device__ __forceinline__ void gla_p2(Frame& F, int L) {
    if (F.wave < 4) {
        const GAS unsigned* U = (const GAS unsigned*)(F.ws + WS_UB); const GAS float* DEC = (const GAS float*)(F.ws + WS_DECAY); GAS unsigned* S = (GAS unsigned*)(F.ws + WS_S);
        for (int e = blockIdx.x * 256 + F.tid; e < BATCH * NH * 4096; e += F.G * 256) {
            const int bh = e >> 12, idx = e & 4095, dk = idx >> 6;
            const GAS unsigned* Up = U + (size_t)bh * NCH * 4096 + idx; const GAS float* dp = DEC + (size_t)bh * NCH * 64 + dk; GAS unsigned* Sp = S + (size_t)bh * NCH * 4096 + idx;
            float s0 = 0.f, s1 = 0.f;
            for (int n0 = 0; n0 < NCH; n0 += 16) {
                unsigned u[16]; float d[16];
#pragma unroll
                for (int i = 0; i < 16; ++i) { u[i] = Up[(size_t)(n0 + i) * 4096]; d[i] = dp[(n0 + i) * 64]; }
#pragma unroll
                for (int i = 0; i < 16; ++i) { Sp[(size_t)(n0 + i) * 4096] = cvt_pk_bf16(s0, s1); s0 = d[i] * s0 + bf_lo(u[i]); s1 = d[i] * s1 + bf_hi(u[i]); }
            }
        }
    } else {
        const GAS bf16* PROJ = (const GAS bf16*)(F.ws + WS_PROJ); GAS bf16* MIX = (GAS bf16*)(F.ws + WS_U);
        const GAS float* cw = ((const GAS float*)F.ap->in[6]) + (size_t)L * 3 * CONVD;
        const int t2 = F.tid - 256, c = 8 * (t2 & 63), tq = t2 >> 6;
        float w0[8], w1[8], w2[8];
        { const f32x4 a = *(const GAS f32x4*)(cw + c), b2 = *(const GAS f32x4*)(cw + c + 4); w0[0] = a[0]; w0[1] = a[1]; w0[2] = a[2]; w0[3] = a[3]; w0[4] = b2[0]; w0[5] = b2[1]; w0[6] = b2[2]; w0[7] = b2[3]; }
        { const f32x4 a = *(const GAS f32x4*)(cw + CONVD + c), b2 = *(const GAS f32x4*)(cw + CONVD + c + 4); w1[0] = a[0]; w1[1] = a[1]; w1[2] = a[2]; w1[3] = a[3]; w1[4] = b2[0]; w1[5] = b2[1]; w1[6] = b2[2]; w1[7] = b2[3]; }
        { const f32x4 a = *(const GAS f32x4*)(cw + 2 * CONVD + c), b2 = *(const GAS f32x4*)(cw + 2 * CONVD + c + 4); w2[0] = a[0]; w2[1] = a[1]; w2[2] = a[2]; w2[3] = a[3]; w2[4] = b2[0]; w2[5] = b2[1]; w2[6] = b2[2]; w2[7] = b2[3]; }
        for (int blk = blockIdx.x; blk < M / 128; blk += F.G) {
            const size_t m0 = (size_t)blk * 128 + 32 * tq;
            float u1[8], u2[8];
            if ((m0 & (SEQ - 1)) == 0) {
#pragma unroll
                for (int j = 0; j < 8; ++j) { u1[j] = 0.f; u2[j] = 0.f; }
            } else {
                const v4u a1 = *(const GAS v4u*)(PROJ + (m0 - 1) * PS + PC_U + c), a2 = *(const GAS v4u*)(PROJ + (m0 - 2) * PS + PC_U + c);
                unpack8(a1, u1); unpack8(a2, u2);
            }
            for (int g0 = 0; g0 < 32; g0 += 8) {
                v4u wu[8], wb[8];
#pragma unroll
                for (int i = 0; i < 8; ++i) { const GAS bf16* rp = PROJ + (m0 + g0 + i) * PS; wu[i] = *(const GAS v4u*)(rp + PC_U + c); wb[i] = *(const GAS v4u*)(rp + PC_CB + c); }
#pragma unroll
                for (int i = 0; i < 8; ++i) { float fu[8], fb[8], y[8]; unpack8(wu[i], fu); unpack8(wb[i], fb);
#pragma unroll
                    for (int j = 0; j < 8; ++j) { const float u0 = fu[j]; y[j] = fb[j] * (w0[j] * u2[j] + w1[j] * u1[j] + w2[j] * u0); u2[j] = u1[j]; u1[j] = u0; }
                    *(GAS v4u*)(MIX + (m0 + g0 + i) * 1024 + 512 + c) = pack8(y); }
            }
        }
    }
}

struct P3Regs { v4u la, qq, kk, vv[2], ss[2], gw[2]; };
__device__ __forceinline__ void p3_load(P3Regs& R, const GAS bf16* PROJ, const GAS bf16* S, int item, int t, int d0, int tid) {
    const int bh = item >> 7, n = item & 127, b = bh >> 2, h = bh & 3; const size_t tok0 = (size_t)b * SEQ + (size_t)n * CHUNK;
    const GAS bf16* row = PROJ + (tok0 + t) * PS;
    R.la = *(const GAS v4u*)(row + PC_LA + 64 * h + d0);
    R.qq = *(const GAS v4u*)(row + PC_Q + 64 * h + d0);
    R.kk = *(const GAS v4u*)(row + PC_K + 64 * h + d0);
#pragma unroll
    for (int i = 0; i < 2; ++i) { R.vv[i] = *(const GAS v4u*)(PROJ + (tok0 + 32 * i + (tid >> 4)) * PS + PC_V + 128 * h + 8 * (tid & 15));
                                  R.ss[i] = *(const GAS v4u*)(S + (size_t)item * 8192 + (size_t)(32 * i + (tid >> 4)) * 128 + 8 * (tid & 15)); }
    const GAS bf16* grow = PROJ + (tok0 + (tid >> 3)) * PS + PC_G + 128 * h + 16 * (tid & 7);
    R.gw[0] = *(const GAS v4u*)(grow); R.gw[1] = *(const GAS v4u*)(grow + 8);
}
__device__ __forceinline__ void gla_p3(Frame& F, int L) {
    const GAS bf16* PROJ = (const GAS bf16*)(F.ws + WS_PROJ); const GAS bf16* S = (const GAS bf16*)(F.ws + WS_S); GAS bf16* MIX = (GAS bf16*)(F.ws + WS_U);
    const GAS float* gn = ((const GAS float*)F.ap->in[7]) + L * DV;
    LAS unsigned char* lds = F.lds + RING_OFF; const int wid = F.wave, lane = F.lane, tid = F.tid;
    const int t = 8 * wid + (lane >> 3), d0 = 8 * (lane & 7);
    const int r = lane & 31, hh = lane >> 5, g1 = (lane >> 4) & 1, q = (lane & 15) >> 2, p = lane & 3;
    const int tt = wid >> 2, dvt = wid & 3;
    f32x4 gnv[4];
#pragma unroll
    for (int i = 0; i < 4; ++i) gnv[i] = *(const GAS f32x4*)(gn + 16 * (tid & 7) + 4 * i);
    P3Regs R;
    if ((int)blockIdx.x < NITEM) p3_load(R, PROJ, S, blockIdx.x, t, d0, tid);
    for (int item = blockIdx.x; item < NITEM; item += F.G) {
        const int bh = item >> 7, n = item & 127, b = bh >> 2, h = bh & 3; const size_t tok0 = (size_t)b * SEQ + (size_t)n * CHUNK;
#pragma unroll
        for (int i = 0; i < 2; ++i) { *(LAS v4u*)(lds + G_VT + (32 * i + (tid >> 4)) * V_STRIDE + (tid & 15) * 16) = R.vv[i];
                                      *(LAS v4u*)(lds + G_ST + (32 * i + (tid >> 4)) * V_STRIDE + (tid & 15) * 16) = R.ss[i]; }
        float bc[8], tot[8]; gla_prefix(R.la, lds, wid, lane, bc, tot);
        { float qf[8], kf[8]; unpack8(R.qq, qf); unpack8(R.kk, kf);
#pragma unroll
          for (int j = 0; j < 8; ++j) { const float e = fast_exp(bc[j]); qf[j] *= e; kf[j] *= fast_rcp(e); }
          *(LAS v4u*)(lds + G_QT + t * QK_STRIDE + d0 * 2) = pack8(qf);
          *(LAS v4u*)(lds + G_KT + t * QK_STRIDE + d0 * 2) = pack8(kf); }
        const v4u gw0 = R.gw[0], gw1 = R.gw[1];
        if (item + F.G < NITEM) p3_load(R, PROJ, S, item + F.G, t, d0, tid);
        LDS_WAIT(); __syncthreads();
        f32x16 o;
#pragma unroll
        for (int i = 0; i < 16; ++i) o[i] = 0.f;
        bf16x8 qfr[4];
#pragma unroll
        for (int ks = 0; ks < 4; ++ks) qfr[ks] = *(LAS bf16x8*)(lds + G_QT + (32 * tt + r) * QK_STRIDE + (16 * ks + 8 * hh) * 2);
#pragma unroll
        for (int ks = 0; ks < 4; ++ks) { LAS unsigned char* bp = lds + G_ST + (16 * ks + 8 * hh + q) * V_STRIDE + (32 * dvt + 16 * g1 + 4 * p) * 2;
            const bf16x8 sb = cat8(tr_read(bp), tr_read(bp + 4 * V_STRIDE));
            o = __builtin_amdgcn_mfma_f32_32x32x16_bf16(qfr[ks], sb, o, 0, 0, 0); }
        for (int st = 0; st <= tt; ++st) {
            f32x16 x;
#pragma unroll
            for (int i = 0; i < 16; ++i) x[i] = 0.f;
#pragma unroll
            for (int ks = 0; ks < 4; ++ks) { const bf16x8 ka = *(LAS bf16x8*)(lds + G_KT + (32 * st + r) * QK_STRIDE + (16 * ks + 8 * hh) * 2);
                x = __builtin_amdgcn_mfma_f32_32x32x16_bf16(ka, qfr[ks], x, 0, 0, 0); }
            if (st == tt) {
#pragma unroll
                for (int i = 0; i < 16; ++i) { const int sl = (i & 3) + 8 * (i >> 2) + 4 * hh; if (sl > r) x[i] = 0.f; } }
#pragma unroll
            for (int k2 = 0; k2 < 2; ++k2) {
                v4u pw; pw.x = cvt_pk_bf16(x[8 * k2 + 0], x[8 * k2 + 1]); pw.y = cvt_pk_bf16(x[8 * k2 + 2], x[8 * k2 + 3]); pw.z = cvt_pk_bf16(x[8 * k2 + 4], x[8 * k2 + 5]); pw.w = cvt_pk_bf16(x[8 * k2 + 6], x[8 * k2 + 7]);
                LAS unsigned char* bp = lds + G_VT + (32 * st + 16 * k2 + 4 * hh + q) * V_STRIDE + (32 * dvt + 16 * g1 + 4 * p) * 2;
                const bf16x8 vb = cat8(tr_read(bp), tr_read(bp + 8 * V_STRIDE));
                o = __builtin_amdgcn_mfma_f32_32x32x16_bf16(__builtin_bit_cast(bf16x8, pw), vb, o, 0, 0, 0); }
        }
        { LAS float* op = (LAS float*)(lds + G_OST + (32 * tt + 4 * hh) * OST_STRIDE) + 32 * dvt + r;
#pragma unroll
          for (int i = 0; i < 16; ++i) op[((i & 3) + 8 * (i >> 2)) * (OST_STRIDE / 4)] = o[i]; }
        LDS_WAIT(); __syncthreads();
        { const int trw = tid >> 3, sg = tid & 7; const LAS f32x4* op = (const LAS f32x4*)(lds + G_OST + trw * OST_STRIDE + sg * 64);
          f32x4 ov[4]; float ssq = 0.f;
#pragma unroll
          for (int i = 0; i < 4; ++i) { ov[i] = op[i]; ssq += (ov[i][0] * ov[i][0] + ov[i][1] * ov[i][1]) + (ov[i][2] * ov[i][2] + ov[i][3] * ov[i][3]); }
          ssq += __shfl_xor(ssq, 1); ssq += __shfl_xor(ssq, 2); ssq += __shfl_xor(ssq, 4);
          const float rs = __builtin_amdgcn_rsqf(ssq * (1.0f / DV) + pg8::RMS_EPS);
          float gf[16]; { float a8[8]; unpack8(gw0, a8);
#pragma unroll
              for (int j = 0; j < 8; ++j) gf[j] = a8[j];
              unpack8(gw1, a8);
#pragma unroll
              for (int j = 0; j < 8; ++j) gf[8 + j] = a8[j]; }
          float res[16];
#pragma unroll
          for (int i = 0; i < 4; ++i)
#pragma unroll
              for (int j = 0; j < 4; ++j) res[4 * i + j] = ov[i][j] * rs * gnv[i][j] * siluf_(gf[4 * i + j]);
          GAS bf16* mrow = MIX + (tok0 + trw) * 1024 + 128 * h + 16 * sg;
          { float a8[8];
#pragma unroll
            for (int j = 0; j < 8; ++j) a8[j] = res[j];
            *(GAS v4u*)(mrow) = pack8(a8);
#pragma unroll
            for (int j = 0; j < 8; ++j) a8[j] = res[8 + j];
            *(GAS v4u*)(mrow + 8) = pack8(a8); } }
    }
}

__device__ __forceinline__ void final_norm(Frame& F, const GAS float* ssq) {
    const int gw = blockIdx.x * NWAVES + F.wave, NGW = F.G * NWAVES;
    static_assert((DEPTH & 1) == 0, "the final residual stream must sit in d_ws (buffer 0), not in d_out");
    const GAS bf16* HB = (const GAS bf16*)(F.ws + WS_HB);
    f32x4 gv[4];
#pragma unroll
    for (int j = 0; j < 2; ++j) { gv[2 * j] = *((const GAS f32x4*)(((const GAS float*)F.ap->in[15]) + 512 * j + 8 * F.lane)); gv[2 * j + 1] = *((const GAS f32x4*)(((const GAS float*)F.ap->in[15]) + 512 * j + 8 * F.lane + 4)); }
    for (int m = gw; m < M; m += NGW) {
        const float rs = pg8::rstd_from(ssq, m);
        const GAS bf16* hr = HB + (size_t)m * DM + 8 * F.lane; GAS float* orow = F.out + (size_t)m * DM + 8 * F.lane;
#pragma unroll
        for (int j = 0; j < 2; ++j) { const v4u w = *(const GAS v4u*)(hr + 512 * j); float f[8]; unpack8(w, f);
            *(GAS f32x4*)(orow + 512 * j) = (f32x4){f[0], f[1], f[2], f[3]} * rs * gv[2 * j];
            *(GAS f32x4*)(orow + 512 * j + 4) = (f32x4){f[4], f[5], f[6], f[7]} * rs * gv[2 * j + 1]; }
    }
}

#ifndef REP_KIND
#define REP_KIND -1
#define REP_N 1
#endif
#ifndef STAGGER_TICKS
#define STAGGER_TICKS 0
#endif
#define STAGGER() do { if (STAGGER_TICKS > 0 && ((blockIdx.x >> 3) & 1)) { const unsigned long long t0_ = __builtin_amdgcn_s_memrealtime(); while (__builtin_amdgcn_s_memrealtime() - t0_ < (unsigned long long)STAGGER_TICKS) __builtin_amdgcn_s_sleep(8); } } while (0)
#ifndef PH_MASK
#define PH_MASK 4095
#endif
__global__ void __launch_bounds__(NWAVES * 64, 2) mega_fwd(Args args) {
    extern __shared__ __attribute__((aligned(16))) unsigned char lds[];
    Frame F;
    F.lds = (LAS unsigned char*)lds;
    F.tid = threadIdx.x; F.lane = F.tid & 63; F.wave = __builtin_amdgcn_readfirstlane(F.tid >> 6);
    F.G = gridDim.x;
    F.ws = (GAS unsigned char*)args.ws; F.out = (GAS float*)args.out; F.ctl = (gu32*)(args.ws + WS_CTL);
    F.ap = (const __attribute__((address_space(4))) Args*)__builtin_amdgcn_kernarg_segment_ptr();
    for (int u = F.tid; u < (LDS_BYTES - LDSCTL_OFF) / 4; u += NWAVES * 64) ((LAS unsigned*)(F.lds + LDSCTL_OFF))[u] = 0u;
    __syncthreads();
    const int lo = args.ph_lo, hi = args.ph_hi;
    XcdBarrier bar; bar.bar = (unsigned*)(F.ctl + CW_BAR); bar.x = 0; bar.st = (volatile LAS unsigned*)(F.lds + MISC_OFF + 32);
    if (hi - lo > 1) bar = xcd_barrier_post((unsigned*)(F.ctl + CW_BAR), (volatile LAS unsigned*)(F.lds + MISC_OFF + 32));

    PG8_LAS float* escr = (PG8_LAS float*)(F.lds + EPI_SCR_OFF);

    for (int ph = lo; ph < hi; ++ph) {
        const int kind_ = (ph == 0) ? 100 : (ph == N_PHASES - 1) ? 101 : ((ph - 1) & 7);
        #ifdef PROBE_NULL_C
        const int nrep = (kind_ == REP_KIND) ? REP_N : 1;
#else
        const int nrep = (kind_ == REP_KIND && !(kind_ == 4 && ph > 8)) ? REP_N : 1;
#endif
        for (int rep = 0; rep < nrep; ++rep) {
        { int t_ = threadIdx.x; asm volatile("" : "+v"(t_)); F.tid = t_; F.lane = t_ & 63; F.wave = __builtin_amdgcn_readfirstlane(t_ >> 6);
          const __attribute__((address_space(4))) Args* a_ = (const __attribute__((address_space(4))) Args*)__builtin_amdgcn_kernarg_segment_ptr(); asm volatile("" : "+s"(a_)); F.ap = a_;
          GAS unsigned char* w_ = (GAS unsigned char*)args.ws; asm volatile("" : "+s"(w_)); F.ws = w_; GAS float* o_ = (GAS float*)args.out; asm volatile("" : "+s"(o_)); F.out = o_; }
        GAS bf16* HB0 = (GAS bf16*)(F.ws + WS_HB); GAS bf16* HB1 = (GAS bf16*)F.out + (size_t)M * DM; GAS bf16* PROJ = (GAS bf16*)(F.ws + WS_PROJ); GAS bf16* MIX = (GAS bf16*)(F.ws + WS_U); GAS bf16* PB = (GAS bf16*)(F.ws + WS_PB);
        GAS float* SSQ[2] = {(GAS float*)(F.ws + WS_SSQ0), (GAS float*)(F.ws + WS_SSQ1)};
        if (ph == 0) { if (PH_MASK & 1) p0_prologue(F); }
        else if (ph == N_PHASES - 1) { if (PH_MASK & 2) final_norm(F, SSQ[0]); }
        else {
            const int L = (ph - 1) >> 3, s = (ph - 1) & 7;
            GAS float* sA = SSQ[L & 1]; GAS float* sB = SSQ[(L & 1) ^ 1];
            GAS bf16* HB = (L & 1) ? HB1 : HB0; GAS bf16* HBN = (L & 1) ? HB0 : HB1;
            if (s == 0) { if (PH_MASK & 4) {
                pg8::Gemm g{(const bf16*)HB, (const bf16*)w_ptr(F, L, WO_IN), M, NPROJ, 1024}; pg8::StaticOrder S; S.init(M, NPROJ, F.G, (int)blockIdx.x);
                STAGGER();
                pg8::EpiProj E{PROJ, PS, sA, ((const GAS float*)F.ap->in[5]) + L * 256};
#ifdef PROBE_NULL_A
                if (rep + 1 < nrep) { pg8::EpiNull E0; pg8::gemm_phase<pg8::EpiNull, pg8::StaticOrder, true, true>(F.lds + RING_OFF, g, S, E0, F.tid); } else
#endif
                pg8::gemm_phase<pg8::EpiProj, pg8::StaticOrder, true, true>(F.lds + RING_OFF, g, S, E, F.tid); }
                { int t_ = F.tid; asm volatile("" : "+v"(t_)); F.tid = t_; }
                if (PH_MASK & 1024) { int kp_ = PLE; asm volatile("" : "+s"(kp_)); pg8::Gemm g{(const bf16*)(PB + (size_t)L * M * PLE), (const bf16*)w_ptr(F, L, WO_PP), M, 1024, kp_};
                  pg8::PPOrder S{F.G, (int)blockIdx.x}; pg8::EpiPP E{(GAS bf16*)F.out, 1024};
                  pg8::gemm_phase<pg8::EpiPP, pg8::PPOrder, true, true>(F.lds + RING_OFF, g, S, E, F.tid); }
            } else if (s == 1) { if (PH_MASK & 8) gla_p1(F, L); }
            else if (s == 2) { if (PH_MASK & 16) gla_p2(F, L); }
            else if (s == 3) { if (PH_MASK & 32) gla_p3(F, L); }
            else if (s == 4) { if (PH_MASK & 64) {
                pg8::Gemm g{(const bf16*)MIX, (const bf16*)w_ptr(F, L, WO_OUT), M, 1024, 1024}; pg8::StaticOrder S; S.init(M, 1024, F.G, (int)blockIdx.x);
                pg8::EpiRes<0> E{nullptr, HB, HB, sB, nullptr, nullptr, escr, F.tid};
#ifdef PROBE_NULL_C
                if (rep + 1 < nrep) { pg8::EpiNull E0; pg8::gemm_phase<pg8::EpiNull, pg8::StaticOrder, true, true>(F.lds + RING_OFF, g, S, E0, F.tid); } else
#endif
                pg8::gemm_phase<pg8::EpiRes<0>, pg8::StaticOrder, true, true>(F.lds + RING_OFF, g, S, E, F.tid); }
            } else if (s == 5) { if (PH_MASK & 128) {
                pg8::Gemm g{(const bf16*)HB, (const bf16*)w_ptr(F, L, WO_GU), M, 2 * FFN, 1024}; pg8::StaticOrder S; S.init(M, 2 * FFN, F.G, (int)blockIdx.x);
                STAGGER();
                pg8::EpiSwiGLU E{PROJ, FFN, sB};
#ifdef PROBE_NORS_D
                if (rep + 1 < nrep) { pg8::EpiSwiGLU_<true> E0{PROJ, FFN, sB}; pg8::gemm_phase<pg8::EpiSwiGLU_<true>, pg8::StaticOrder, true, true>(F.lds + RING_OFF, g, S, E0, F.tid); } else
#endif
                pg8::gemm_phase<pg8::EpiSwiGLU, pg8::StaticOrder, true, true>(F.lds + RING_OFF, g, S, E, F.tid); }
            } else if (s == 6) { if (PH_MASK & 256) {
                pg8::Gemm g{(const bf16*)PROJ, (const bf16*)w_ptr(F, L, WO_DN), M, 1024, FFN}; pg8::StaticOrder S; S.init(M, 1024, F.G, (int)blockIdx.x);
                pg8::EpiRes<0> E{nullptr, HB, HB, sA, nullptr, nullptr, escr, F.tid};
#ifdef PROBE_NULL_E
                if (rep + 1 < nrep) { pg8::EpiNull E0; pg8::gemm_phase<pg8::EpiNull, pg8::StaticOrder, true, true>(F.lds + RING_OFF, g, S, E0, F.tid); } else
#endif
                pg8::gemm_phase<pg8::EpiRes<0>, pg8::StaticOrder, true, true>(F.lds + RING_OFF, g, S, E, F.tid); }
            } else { if (PH_MASK & 512) {
                if (PH_MASK & 2048) { pg8::Gemm g{(const bf16*)HB, (const bf16*)w_ptr(F, L, WO_PG), M, 1024, 1024}; pg8::StaticOrder S; S.init(M, 1024, F.G, (int)blockIdx.x);
                  pg8::EpiRes<1> E{nullptr, HB, HBN, sB, sA, (const GAS bf16*)F.out, escr, F.tid};
#ifdef PROBE_NULL_F
                  if (rep + 1 < nrep) { pg8::EpiNull E0; pg8::gemm_phase<pg8::EpiNull, pg8::StaticOrder, true, true>(F.lds + RING_OFF, g, S, E0, F.tid); } else
#endif
                  pg8::gemm_phase<pg8::EpiRes<1>, pg8::StaticOrder, true, true>(F.lds + RING_OFF, g, S, E, F.tid); } }
            }
        }
        if (rep + 1 < nrep) xcd_barrier(bar);
        }
        if (ph + 1 < hi) xcd_barrier(bar);
#ifdef PROBE_XBAR
        if (ph + 1 < hi) { xcd_barrier(bar); xcd_barrier(bar); }
#endif
    }
}

#ifndef MK_ONE_LAUNCH
#define MK_ONE_LAUNCH 1
#endif
extern "C" void kernel_launch(void* const* d_in, const int* in_sizes, int n_in, void* d_out, int out_size, void* d_ws, size_t ws_size, hipStream_t stream) {
    static int grid = 0;
    if (grid == 0) {
        if (n_in != 16 || in_sizes[0] != M * DM || out_size != M * DM || ws_size < WS_END) { fprintf(stderr, "kernel_launch: unexpected shapes / workspace (%d inputs, in0 %d, out %d, ws %zu)\n", n_in, n_in > 0 ? in_sizes[0] : -1, out_size, ws_size); grid = -1; return; }
        int dev = 0, cus = 0, per_cu = 0;
        if (hipGetDevice(&dev) != hipSuccess || hipDeviceGetAttribute(&cus, hipDeviceAttributeMultiprocessorCount, dev) != hipSuccess) { grid = -1; return; }
        if (hipFuncSetAttribute((const void*)mega_fwd, hipFuncAttributeMaxDynamicSharedMemorySize, LDS_BYTES) != hipSuccess) { fprintf(stderr, "kernel_launch: hipFuncSetAttribute failed\n"); grid = -1; return; }
        if (hipOccupancyMaxActiveBlocksPerMultiprocessor(&per_cu, (const void*)mega_fwd, NWAVES * 64, LDS_BYTES) != hipSuccess || per_cu < 1) { fprintf(stderr, "kernel_launch: occupancy query says %d blocks per CU\n", per_cu); (void)hipGetLastError(); grid = -1; return; }
        grid = cus;
    }
    if (grid < 0) return;
    (void)hipMemsetAsync((char*)d_ws + WS_CTL, 0, CTL_ZERO_BYTES, stream);
    Args a{};
    for (int i = 0; i < 16; ++i) a.in[i] = (const float*)d_in[i];
    a.out = (float*)d_out; a.ws = (unsigned char*)d_ws;
#if MK_ONE_LAUNCH
    a.ph_lo = 0; a.ph_hi = N_PHASES;
    void* kargs[] = {&a};
    hipError_t e = hipLaunchCooperativeKernel((const void*)mega_fwd, dim3(grid), dim3(NWAVES * 64), kargs, LDS_BYTES, stream);
    if (e != hipSuccess) fprintf(stderr, "kernel_launch: cooperative launch failed: %s (grid %d)\n", hipGetErrorString(e), grid);
#else
    for (int ph = 0; ph < N_PHASES; ++ph) { a.ph_lo = ph; a.ph_hi = ph + 1; hipLaunchKernelGGL(mega_fwd, dim3(grid), dim3(NWAVES * 64), LDS_BYTES, stream, a); }
#endif
}
```

```cpp
#include <hip/hip_runtime.h>
#include <cstdio>
#include <cstdint>
namespace pg8 {
#define PG8_LAS __attribute__((address_space(3)))
typedef unsigned short bf16_t;
typedef short bf16x8 __attribute__((ext_vector_type(8)));
typedef float f32x4 __attribute__((ext_vector_type(4)));
typedef unsigned u32x4 __attribute__((ext_vector_type(4)));
constexpr int BM = 256, BK = 64, HALF = 128, HTB = HALF * BK * 2  , STAGE_BYTES = 8 * HTB, NXCD = 8, WGM = 8;

__host__ __device__ __forceinline__ int lds_byte(int r, int c) { const int st = (r >> 4) * 2 + (c >> 5), rr = r & 15, cc = c & 31, ob = rr * 64 + cc * 2; return st * 1024 + (ob ^ (((ob >> 9) & 1) << 5)); }
__host__ __device__ __forceinline__ void stage_rc(int b, int& R, int& C) { const int st = b / 1024, sb = b % 1024, swz = sb ^ (((sb >> 9) & 1) << 5); R = (st >> 1) * 16 + swz / 64; C = (st & 1) * 32 + (swz % 64) / 2; }
__host__ __device__ __forceinline__ int perm32(int rho) { const int n = rho >> 4, i = rho & 15; return 8 * (i >> 2) + 4 * n + (i & 3); }

struct Unit { int pm, pn; };
struct Gemm { const bf16_t* A; const bf16_t* Bt; int M, N, K; };

struct StaticOrder {
    int nM, nN, nwg, G, c;
    __host__ __device__ void init(int M, int N, int G_, int c_) { nM = M / BM; nN = N / BM; nwg = nM * nN; G = G_; c = c_; }
    __host__ __device__ bool next(int i, Unit& u) const {
        const long L = (long)i * G + c; if (L >= nwg) return false;
        int wgid = (int)L; { const int q = nwg / NXCD, r = nwg % NXCD, xcd = wgid % NXCD, off = wgid / NXCD; wgid = (xcd < r ? xcd * (q + 1) : r * (q + 1) + (xcd - r) * q) + off; }
        const int nig = WGM * nN, gid = wgid / nig, fm = gid * WGM, gsz = (nM - fm) < WGM ? (nM - fm) : WGM;
        u.pm = fm + ((wgid % nig) % gsz); u.pn = (wgid % nig) / gsz; return true;
    }
    __device__ __forceinline__ void a_ready(const Unit&) const {}
    __device__ __forceinline__ void done(const Unit&) const {}
};


typedef float f32x2_cv __attribute__((ext_vector_type(2))); typedef __bf16 bf16x2_cv __attribute__((ext_vector_type(2)));
__device__ __forceinline__ unsigned cvt_pk_bf16(float lo, float hi) { const f32x2_cv v = {lo, hi}; const bf16x2_cv b = __builtin_convertvector(v, bf16x2_cv); return __builtin_bit_cast(unsigned, b); }
typedef unsigned u32x2 __attribute__((ext_vector_type(2)));
#define PG8_GAS __attribute__((address_space(1)))
constexpr float RMS_EPS = 1e-6f;
__device__ __forceinline__ float fast_rcp(float x) { return __builtin_amdgcn_rcpf(x); }
__device__ __forceinline__ float fast_exp(float x) { return __builtin_amdgcn_exp2f(x * 1.4426950408889634f); }
__device__ __forceinline__ float fast_log(float x) { return __builtin_amdgcn_logf(x) * 0.6931471805599453f; }
__device__ __forceinline__ float sigmoidf_(float x) { return fast_rcp(1.0f + fast_exp(-x)); }
__device__ __forceinline__ float siluf_(float x) { return x * sigmoidf_(x); }
__device__ __forceinline__ float logsig16(float x) { return (fminf(x, 0.f) - fast_log(1.0f + fast_exp(-fabsf(x)))) * 0.0625f; }
__device__ __forceinline__ float rstd_from(const PG8_GAS float* ssq, int row) { const f32x4 s = *(const PG8_GAS f32x4*)(ssq + (size_t)row * 4); return __builtin_amdgcn_rsqf(((s[0] + s[1]) + (s[2] + s[3])) * (1.0f / 1024.0f) + RMS_EPS); }

__device__ __forceinline__ float rstd_tab(const PG8_LAS unsigned char* tab, int par, int rl) { const f32x4 s = *(const PG8_LAS f32x4*)(tab + par * 4096 + rl * 16); return __builtin_amdgcn_rsqf(((s[0] + s[1]) + (s[2] + s[3])) * (1.0f / 1024.0f) + RMS_EPS); }
struct RstdOrder : StaticOrder {
    const PG8_GAS float* ssq; PG8_LAS unsigned char* tab; int tid; mutable int cnt;
    __device__ __forceinline__ void a_ready(const Unit& u) const {
        const int w = __builtin_amdgcn_readfirstlane(tid >> 6);
        if (w < 4) __builtin_amdgcn_global_load_lds((const unsigned*)(ssq + (size_t)(u.pm * BM + tid) * 4), (PG8_LAS unsigned*)(tab + (cnt & 1) * 4096 + w * 1024), 16, 0, 0);
        ++cnt;
    }
};
struct EpiProj {
    static constexpr bool PERM = true, AFTER_DRAIN = false;
    PG8_GAS bf16_t* O; int ldc; const PG8_LAS unsigned char* tab; const PG8_GAS float* bgate; mutable int ui;
    __device__ __forceinline__ void operator()(const f32x4 (&acc)[2][2][4][2], const Unit& u, int wr, int wc, int fr, int fq) const {
        const int row0 = u.pm * BM + wr * 64 + fr, rl0 = wr * 64 + fr, par = ui & 1; ++ui;
        const int kind = (u.pn == 12) ? 2 : (u.pn >= 8 ? 1 : 0);
        if (kind == 1) {
            const int col0 = 2048 + (u.pn - 8) * HALF + wc * 32 + 8 * fq;
#pragma unroll
            for (int ai = 0; ai < 2; ++ai)
#pragma unroll
                for (int m = 0; m < 4; ++m) { const int row = row0 + ai * HALF + m * 16; const float rs = rstd_tab(tab, par, rl0 + ai * HALF + m * 16), rs2 = rs * rs;
                    const f32x4 h0 = acc[ai][0][m][0] * acc[ai][1][m][0] * rs2, h1 = acc[ai][0][m][1] * acc[ai][1][m][1] * rs2;
                    u32x4 w; w.x = cvt_pk_bf16(h0[0], h0[1]); w.y = cvt_pk_bf16(h0[2], h0[3]); w.z = cvt_pk_bf16(h1[0], h1[1]); w.w = cvt_pk_bf16(h1[2], h1[3]);
                    *(PG8_GAS u32x4*)(O + (size_t)row * ldc + col0) = w; }
            return;
        }
        const bool isg = (kind == 2);
        const int col0 = (isg ? 2560 : u.pn * BM) + wc * 32 + 8 * fq;
        f32x4 bv[2][2];
#pragma unroll
        for (int bj = 0; bj < 2; ++bj)
#pragma unroll
            for (int n = 0; n < 2; ++n) bv[bj][n] = isg ? *(const PG8_GAS f32x4*)(bgate + wc * 32 + 8 * fq + bj * HALF + 4 * n) : (f32x4){0.f, 0.f, 0.f, 0.f};
#pragma unroll
        for (int ai = 0; ai < 2; ++ai)
#pragma unroll
            for (int m = 0; m < 4; ++m) { const int row = row0 + ai * HALF + m * 16; const float rs = rstd_tab(tab, par, rl0 + ai * HALF + m * 16); PG8_GAS bf16_t* rowp = O + (size_t)row * ldc + col0;
#pragma unroll
                for (int bj = 0; bj < 2; ++bj) { f32x4 v0 = acc[ai][bj][m][0] * rs, v1 = acc[ai][bj][m][1] * rs;
                    if (isg) { v0 = v0 + bv[bj][0]; v1 = v1 + bv[bj][1];
#pragma unroll
                        for (int i = 0; i < 4; ++i) { v0[i] = logsig16(v0[i]); v1[i] = logsig16(v1[i]); } }
                    u32x4 w; w.x = cvt_pk_bf16(v0[0], v0[1]); w.y = cvt_pk_bf16(v0[2], v0[3]); w.z = cvt_pk_bf16(v1[0], v1[1]); w.w = cvt_pk_bf16(v1[2], v1[3]);
                    *(PG8_GAS u32x4*)(rowp + bj * HALF) = w; } }
    }
};
template <bool NORS = false> struct EpiSwiGLU_ {
    static constexpr bool PERM = true, AFTER_DRAIN = false;
    PG8_GAS bf16_t* O; int ldc; const PG8_LAS unsigned char* tab; mutable int ui;
    __device__ __forceinline__ void operator()(const f32x4 (&acc)[2][2][4][2], const Unit& u, int wr, int wc, int fr, int fq) const {
        const int row0 = u.pm * BM + wr * 64 + fr, col0 = u.pn * HALF + wc * 32 + 8 * fq, rl0 = wr * 64 + fr, par = ui & 1; ++ui;
#pragma unroll
        for (int ai = 0; ai < 2; ++ai)
#pragma unroll
            for (int m = 0; m < 4; ++m) { const int row = row0 + ai * HALF + m * 16; const float rs = NORS ? 1.0f : rstd_tab(tab, par, rl0 + ai * HALF + m * 16); const float k1 = rs * -1.4426950408889634f, k2 = rs * rs;
                f32x4 h0, h1;
                { const f32x4 a = acc[ai][0][m][0], b = acc[ai][1][m][0]; const f32x4 num = a * b * k2, ex = a * k1;
#pragma unroll
                  for (int i = 0; i < 4; ++i) h0[i] = num[i] * fast_rcp(1.0f + __builtin_amdgcn_exp2f(ex[i])); }
                { const f32x4 a = acc[ai][0][m][1], b = acc[ai][1][m][1]; const f32x4 num = a * b * k2, ex = a * k1;
#pragma unroll
                  for (int i = 0; i < 4; ++i) h1[i] = num[i] * fast_rcp(1.0f + __builtin_amdgcn_exp2f(ex[i])); }
                u32x4 w; w.x = cvt_pk_bf16(h0[0], h0[1]); w.y = cvt_pk_bf16(h0[2], h0[3]); w.z = cvt_pk_bf16(h1[0], h1[1]); w.w = cvt_pk_bf16(h1[2], h1[3]);
                *(PG8_GAS u32x4*)(O + (size_t)row * ldc + col0) = w; }
    }
};
typedef EpiSwiGLU_<false> EpiSwiGLU;
struct EpiPP {
    static constexpr bool PERM = true, AFTER_DRAIN = false;
    PG8_GAS bf16_t* O; int ldc;
    __device__ __forceinline__ void operator()(const f32x4 (&acc)[2][2][4][2], const Unit& u, int wr, int wc, int fr, int fq) const {
        const int row0 = u.pm * BM + wr * 64 + fr, col0 = u.pn * BM + wc * 32 + 8 * fq;
#pragma unroll
        for (int ai = 0; ai < 2; ++ai)
#pragma unroll
            for (int m = 0; m < 4; ++m) { PG8_GAS bf16_t* rowp = O + (size_t)(row0 + ai * HALF + m * 16) * ldc + col0;
#pragma unroll
                for (int bj = 0; bj < 2; ++bj) { const f32x4 v0 = acc[ai][bj][m][0], v1 = acc[ai][bj][m][1];
                    u32x4 w; w.x = cvt_pk_bf16(v0[0], v0[1]); w.y = cvt_pk_bf16(v0[2], v0[3]); w.z = cvt_pk_bf16(v1[0], v1[1]); w.w = cvt_pk_bf16(v1[2], v1[3]);
                    *(PG8_GAS u32x4*)(rowp + bj * HALF) = w; } }
    }
};
template <int MODE> struct EpiRes {
    static constexpr bool PERM = false, AFTER_DRAIN = false;
    const PG8_GAS float* basef; const PG8_GAS bf16_t* hbin; PG8_GAS bf16_t* hb; PG8_GAS float* ssq_out; const PG8_LAS unsigned char* tab; const PG8_GAS bf16_t* pp; PG8_LAS float* scr; int tid; mutable int ui;
    __device__ __forceinline__ void operator()(const f32x4 (&acc_)[2][2][4][2], const Unit& u, int wr, int wc, int fr, int fq) const {
        f32x4 (&acc)[2][2][4][2] = const_cast<f32x4 (&)[2][2][4][2]>(acc_);
        const int col0 = u.pn * BM + wc * 32 + 4 * fq, par = ui & 1; ++ui;
        if (MODE == 1) {
#pragma unroll
            for (int ai = 0; ai < 2; ++ai)
#pragma unroll
                for (int m = 0; m < 4; ++m) { const int row = u.pm * BM + ai * HALF + wr * 64 + m * 16 + fr; const PG8_GAS bf16_t* pr = pp + (size_t)row * 1024 + col0;
                    const float rs = rstd_tab(tab, par, ai * HALF + wr * 64 + m * 16 + fr);
#pragma unroll
                    for (int bj = 0; bj < 2; ++bj)
#pragma unroll
                        for (int n = 0; n < 2; ++n) { const u32x2 pw = *(const PG8_GAS u32x2*)(pr + bj * HALF + n * 16); f32x4 v = acc[ai][bj][m][n];
                            v[0] = sigmoidf_(v[0] * rs) * __uint_as_float(pw.x << 16); v[1] = sigmoidf_(v[1] * rs) * __uint_as_float(pw.x & 0xffff0000u);
                            v[2] = sigmoidf_(v[2] * rs) * __uint_as_float(pw.y << 16); v[3] = sigmoidf_(v[3] * rs) * __uint_as_float(pw.y & 0xffff0000u); acc[ai][bj][m][n] = v; }
                    asm volatile("" : "+v"(acc[ai][0][m][0]), "+v"(acc[ai][0][m][1]), "+v"(acc[ai][1][m][0]), "+v"(acc[ai][1][m][1]));
                    asm volatile("" ::: "memory"); }
        }
#pragma unroll
        for (int ai = 0; ai < 2; ++ai)
#pragma unroll
            for (int m = 0; m < 4; ++m) { const int rl = ai * HALF + wr * 64 + m * 16 + fr, row = u.pm * BM + rl; const size_t off = (size_t)row * 1024 + col0;
                float part = 0.f;
#pragma unroll
                for (int bj = 0; bj < 2; ++bj)
#pragma unroll
                    for (int n = 0; n < 2; ++n) { const size_t c = off + bj * HALF + n * 16; const f32x4 v = acc[ai][bj][m][n];
                        f32x4 b;
                        if (basef) b = *(const PG8_GAS f32x4*)(basef + c);
                        else { const u32x2 bw = *(const PG8_GAS u32x2*)(hbin + c); b[0] = __uint_as_float(bw.x << 16); b[1] = __uint_as_float(bw.x & 0xffff0000u); b[2] = __uint_as_float(bw.y << 16); b[3] = __uint_as_float(bw.y & 0xffff0000u); }
                        const f32x4 o = b + v;
                        { u32x2 w; w.x = cvt_pk_bf16(o[0], o[1]); w.y = cvt_pk_bf16(o[2], o[3]); *(PG8_GAS u32x2*)(hb + c) = w; }
                        part += (o[0] * o[0] + o[1] * o[1]) + (o[2] * o[2] + o[3] * o[3]); }
                part += __shfl_xor(part, 16); part += __shfl_xor(part, 32);
                if (fq == 0) scr[rl * 4 + wc] = part;
                if (m & 1) asm volatile("" ::: "memory"); }
        asm volatile("s_waitcnt lgkmcnt(0)" ::: "memory"); __builtin_amdgcn_s_barrier(); asm volatile("" ::: "memory");
        { const int t = tid & 255;
          if (t < 128) { const int rl = (t >> 6) * HALF + wr * 64 + (t & 63); const f32x4 p4 = *(const PG8_LAS f32x4*)(scr + rl * 4);
              ssq_out[(size_t)(u.pm * BM + rl) * 4 + u.pn] = (p4[0] + p4[1]) + (p4[2] + p4[3]); } }
        asm volatile("s_waitcnt lgkmcnt(0)" ::: "memory");
    }
};
struct PPOrder {
    int G, c;
    __device__ __forceinline__ bool next(int i, Unit& u) const {
        int idx;
        if (G == 256) { if (c < 128) { if (i >= 1) return false; idx = 384 + c; } else { if (i >= 3) return false; idx = 3 * (c - 128) + i; } }
        else { idx = i * G + c; if (idx >= 512) return false; }
        u.pm = idx >> 2; u.pn = idx & 3; return true;
    }
    __device__ __forceinline__ void a_ready(const Unit&) const {}
    __device__ __forceinline__ void done(const Unit&) const {}
};
struct EpiNull {
    static constexpr bool PERM = true, AFTER_DRAIN = false;
    __device__ __forceinline__ void operator()(const f32x4 (&acc)[2][2][4][2], const Unit& u, int wr, int wc, int fr, int fq) const {
#pragma unroll
        for (int ai = 0; ai < 2; ++ai)
#pragma unroll
            for (int bj = 0; bj < 2; ++bj)
#pragma unroll
                for (int m = 0; m < 4; ++m)
#pragma unroll
                    for (int n = 0; n < 2; ++n) asm volatile("" :: "v"(acc[ai][bj][m][n]));
    }
};
template <class Epi, class Sched, bool ALIGN_EPI = false, bool SP2 = false>
__device__ __forceinline__ void gemm_phase(PG8_LAS unsigned char* lds, const Gemm g, const Sched& S, const Epi& E, const int tid) {
    const int wid = __builtin_amdgcn_readfirstlane(tid >> 6), lane = tid & 63, wr = wid >> 2, wc = wid & 3, fr = lane & 15, fq = lane >> 4;
    const int K = g.K, nt = K / BK;
    unsigned voffA[2], voffB[2];
#pragma unroll
    for (int i = 0; i < 2; ++i) { int R, C; stage_rc(tid * 16 + i * 8192, R, C); const int Rb = Epi::PERM ? ((R & ~31) + perm32(R & 31)) : R;
        voffA[i] = (unsigned)(R * K + C) * 2u; voffB[i] = (unsigned)(Rb * K + C) * 2u; }
    const size_t kstep = (size_t)(BK * 2);
    const size_t hstep = (size_t)HALF * K * 2;
    const size_t tstep = 2 * hstep;
    const unsigned ldsw = (unsigned)wid * 1024u;
    const int aoff = lds_byte(wr * 64 + fr, fq * 8), boff = lds_byte(wc * 32 + fr, fq * 8);
#define PG8_SA(b, h) (((b) * 2 + (h)) * HTB)
#define PG8_SB(b, h) ((4 + (b) * 2 + (h)) * HTB)
#define PG8_STAGE(bufoff, gbase, voff) do { _Pragma("unroll") for (int _i = 0; _i < 2; ++_i) \
        __builtin_amdgcn_global_load_lds((const unsigned*)((const char*)(gbase) + (voff)[_i]), (PG8_LAS unsigned*)(lds + (bufoff) + ldsw + _i * 8192), 16, 0, 0); } while (0)
#define PG8_LDA(dst, b, h) do { _Pragma("unroll") for (int m = 0; m < 4; ++m) _Pragma("unroll") for (int k = 0; k < 2; ++k) dst[m][k] = *(const PG8_LAS bf16x8*)(lds + PG8_SA(b, h) + aoff + m * 2048 + k * 1024); } while (0)
#define PG8_LDB(dst, b, h) do { _Pragma("unroll") for (int n = 0; n < 2; ++n) _Pragma("unroll") for (int k = 0; k < 2; ++k) dst[n][k] = *(const PG8_LAS bf16x8*)(lds + PG8_SB(b, h) + boff + n * 2048 + k * 1024); } while (0)
#define PG8_MMA(ai, bj, At, Bt) do { __builtin_amdgcn_s_setprio(1); _Pragma("unroll") for (int m = 0; m < 4; ++m) _Pragma("unroll") for (int n = 0; n < 2; ++n) _Pragma("unroll") for (int k = 0; k < 2; ++k) \
        acc[ai][bj][m][n] = __builtin_amdgcn_mfma_f32_16x16x32_bf16(Bt[n][k], At[m][k], acc[ai][bj][m][n], 0, 0, 0); __builtin_amdgcn_s_setprio(0); } while (0)
#define PG8_WAIT_V(n) asm volatile("s_waitcnt vmcnt(" #n ")" ::: "memory")
#define PG8_WAIT_L(n) asm volatile("s_waitcnt lgkmcnt(" #n ")" ::: "memory")
#define PG8_BAR __builtin_amdgcn_s_barrier()
#define PG8_SCHED __builtin_amdgcn_sched_barrier(0)
    Unit cur, nxt; int ui = 0;
    if (!S.next(0, cur)) return;
    f32x4 acc[2][2][4][2];
#pragma unroll
    for (int a = 0; a < 2; ++a)
#pragma unroll
        for (int b = 0; b < 2; ++b)
#pragma unroll
            for (int m = 0; m < 4; ++m)
#pragma unroll
                for (int n = 0; n < 2; ++n) acc[a][b][m][n] = (f32x4){0.f, 0.f, 0.f, 0.f};
    bf16x8 At[4][2], B0[2][2], B1[2][2];
    const char* cA = (const char*)g.A + (size_t)cur.pm * tstep; const char* cB = (const char*)g.Bt + (size_t)cur.pn * tstep;
    S.a_ready(cur);
    if constexpr (SP2) {
        PG8_STAGE(PG8_SB(0, 0), cB, voffB); PG8_STAGE(PG8_SB(0, 1), cB + hstep, voffB); PG8_STAGE(PG8_SA(0, 0), cA, voffA); PG8_STAGE(PG8_SA(0, 1), cA + hstep, voffA);
        if (wr == 1) PG8_BAR;
        PG8_WAIT_V(2); PG8_BAR;
        PG8_STAGE(PG8_SB(1, 0), cB + kstep, voffB); PG8_STAGE(PG8_SA(1, 0), cA + kstep, voffA); PG8_STAGE(PG8_SB(1, 1), cB + hstep + kstep, voffB);
        PG8_WAIT_V(6); PG8_BAR;
    } else {
        PG8_STAGE(PG8_SB(0, 0), cB, voffB); PG8_STAGE(PG8_SA(0, 0), cA, voffA); PG8_STAGE(PG8_SB(0, 1), cB + hstep, voffB); PG8_STAGE(PG8_SA(0, 1), cA + hstep, voffA);
        if (wr == 1) PG8_BAR;
        PG8_WAIT_V(4); PG8_BAR;
        PG8_STAGE(PG8_SB(1, 0), cB + kstep, voffB); PG8_STAGE(PG8_SA(1, 0), cA + kstep, voffA); PG8_STAGE(PG8_SB(1, 1), cB + hstep + kstep, voffB);
        PG8_WAIT_V(6); PG8_BAR;
    }
    for (;;) {
        const bool has_next = S.next(ui + 1, nxt);
        const char* nA = has_next ? (const char*)g.A + (size_t)nxt.pm * tstep : cA; const char* nB = has_next ? (const char*)g.Bt + (size_t)nxt.pn * tstep : cB;
        for (int t = 0; t < nt; t += 2) {
            const bool last = (t == nt - 2);
            const char* a1 = cA + (size_t)(t + 1) * kstep;
            const char* a2 = last ? nA : cA + (size_t)(t + 2) * kstep; const char* b2 = last ? nB : cB + (size_t)(t + 2) * kstep;
            const char* a3 = a2 + kstep; const char* b3 = b2 + kstep;
            if (last && has_next) S.a_ready(nxt);
            if constexpr (SP2) {
            PG8_LDB(B0, 0, 0); PG8_LDB(B1, 0, 1); PG8_SCHED; PG8_LDA(At, 0, 0); PG8_STAGE(PG8_SA(1, 1), a1 + hstep, voffA);
            PG8_WAIT_V(8); PG8_WAIT_L(0); PG8_BAR; PG8_MMA(0, 0, At, B0); PG8_MMA(0, 1, At, B1); PG8_BAR; PG8_SCHED;
            PG8_LDA(At, 0, 1); PG8_STAGE(PG8_SB(0, 0), b2, voffB); PG8_STAGE(PG8_SB(0, 1), b2 + hstep, voffB); PG8_STAGE(PG8_SA(0, 0), a2, voffA);
            PG8_WAIT_V(8); PG8_WAIT_L(0); PG8_BAR; PG8_MMA(1, 0, At, B0); PG8_MMA(1, 1, At, B1); PG8_BAR; PG8_SCHED;
            PG8_LDB(B0, 1, 0); PG8_LDB(B1, 1, 1); PG8_SCHED; PG8_LDA(At, 1, 0); PG8_STAGE(PG8_SA(0, 1), a2 + hstep, voffA);
            PG8_WAIT_V(8); PG8_WAIT_L(0); PG8_BAR; PG8_MMA(0, 0, At, B0); PG8_MMA(0, 1, At, B1); PG8_BAR; PG8_SCHED;
            PG8_LDA(At, 1, 1); PG8_STAGE(PG8_SB(1, 0), b3, voffB); PG8_STAGE(PG8_SB(1, 1), b3 + hstep, voffB); PG8_STAGE(PG8_SA(1, 0), a3, voffA);
            PG8_WAIT_V(8); PG8_WAIT_L(0); PG8_BAR; PG8_MMA(1, 0, At, B0); PG8_MMA(1, 1, At, B1); PG8_BAR; PG8_SCHED;
            } else {
            PG8_LDB(B0, 0, 0); PG8_SCHED; PG8_LDA(At, 0, 0); PG8_STAGE(PG8_SA(1, 1), a1 + hstep, voffA);
            PG8_WAIT_L(8); PG8_BAR; PG8_WAIT_L(0); PG8_MMA(0, 0, At, B0); PG8_BAR; PG8_SCHED;
            PG8_LDB(B1, 0, 1); PG8_STAGE(PG8_SB(0, 0), b2, voffB);
            PG8_BAR; PG8_WAIT_L(0); PG8_MMA(0, 1, At, B1); PG8_BAR;
            PG8_LDA(At, 0, 1); PG8_STAGE(PG8_SA(0, 0), a2, voffA);
            PG8_BAR; PG8_WAIT_L(0); PG8_MMA(1, 0, At, B0); PG8_BAR; PG8_SCHED;
            PG8_STAGE(PG8_SB(0, 1), b2 + hstep, voffB);
            PG8_WAIT_V(6); PG8_BAR; PG8_MMA(1, 1, At, B1); PG8_BAR;
            PG8_LDB(B0, 1, 0); PG8_SCHED; PG8_LDA(At, 1, 0); PG8_STAGE(PG8_SA(0, 1), a2 + hstep, voffA);
            PG8_WAIT_L(8); PG8_BAR; PG8_WAIT_L(0); PG8_MMA(0, 0, At, B0); PG8_BAR; PG8_SCHED;
            PG8_LDB(B1, 1, 1); PG8_STAGE(PG8_SB(1, 0), b3, voffB);
            PG8_BAR; PG8_WAIT_L(0); PG8_MMA(0, 1, At, B1); PG8_BAR;
            PG8_LDA(At, 1, 1); PG8_STAGE(PG8_SA(1, 0), a3, voffA);
            PG8_BAR; PG8_WAIT_L(0); PG8_MMA(1, 0, At, B0); PG8_BAR; PG8_SCHED;
            PG8_STAGE(PG8_SB(1, 1), b3 + hstep, voffB);
            PG8_WAIT_V(6); PG8_BAR; PG8_MMA(1, 1, At, B1); PG8_BAR;
            }
        }
        if constexpr (ALIGN_EPI) { if (wr == 0) PG8_BAR; }
        if constexpr (!Epi::AFTER_DRAIN) { E(acc, cur, wr, wc, fr, fq); S.done(cur); }
        if (!has_next) break;
#pragma unroll
        for (int a = 0; a < 2; ++a)
#pragma unroll
            for (int b = 0; b < 2; ++b)
#pragma unroll
                for (int m = 0; m < 4; ++m)
#pragma unroll
                    for (int n = 0; n < 2; ++n) acc[a][b][m][n] = (f32x4){0.f, 0.f, 0.f, 0.f};
        cur = nxt; cA = nA; cB = nB; ++ui;
        if constexpr (ALIGN_EPI) { if (wr == 1) PG8_BAR; }
    }
    PG8_WAIT_V(0);
    if constexpr (!ALIGN_EPI) { if (wr == 0) PG8_BAR; }
    PG8_BAR;
    if constexpr (Epi::AFTER_DRAIN) { E.fused(acc, cur, wr, wc, fr, fq, lds, wid, lane); S.done(cur); }
#undef PG8_SA
#undef PG8_SB
#undef PG8_STAGE
#undef PG8_LDA
#undef PG8_LDB
#undef PG8_MMA
#undef PG8_WAIT_V
#undef PG8_WAIT_L
#undef PG8_BAR
#undef PG8_SCHED
}
}

constexpr int NWAVES = 8;
constexpr int BATCH = 4, SEQ = 8192, DM = 1024, DEPTH = 2, M = BATCH * SEQ;
constexpr int NH = 4, DK = 64, DV = 128, CHUNK = 64, NCH = SEQ / CHUNK;
constexpr int NITEM = BATCH * NH * NCH;
constexpr int IN_DIM = 3088, FFN = 2816, PLE = 256, CONVD = 512;
constexpr int NPROJ = 3328;
constexpr int PS = 2816;
constexpr int PC_Q = 0, PC_K = 256, PC_V = 512, PC_G = 1024, PC_CB = 1536, PC_U = 2048, PC_LA = 2560;
constexpr int N_PHASES = 18;

constexpr size_t MiB = 1u << 20;
constexpr size_t WS_CTL = 0, CTL_ZERO_BYTES = 1 * MiB;
constexpr size_t WS_SSQ0 = 1 * MiB, WS_SSQ1 = 1 * MiB + 512 * 1024;
constexpr size_t WS_DECAY = 2 * MiB;
constexpr size_t WS_W = 4 * MiB, W_LAYER = 28 * MiB;
constexpr size_t WO_IN = 0, WO_OUT = 6815744, WO_GU = WO_OUT + 2 * MiB, WO_DN = WO_GU + 11 * MiB, WO_PG = WO_DN + 5767168, WO_PP = WO_PG + 2 * MiB;
static_assert(WO_PP + 512 * 1024 <= W_LAYER, "weights per layer");
constexpr size_t WS_HB = 64 * MiB;
constexpr size_t WS_PROJ = 128 * MiB;
constexpr size_t WS_U = 336 * MiB;
constexpr size_t WS_S = 400 * MiB;
constexpr size_t WS_PB = 432 * MiB;
constexpr size_t WS_UB = 464 * MiB;
constexpr size_t WS_END = 496 * MiB;
constexpr int CW_BAR = 4096;

constexpr int RING_OFF = 0, RING_BYTES = 131072;
constexpr int EPI_SCR_OFF = RING_BYTES;
constexpr int RSTD_TAB_OFF = RING_BYTES + 4096;
constexpr int LDSCTL_OFF = RING_BYTES + 4096 + 8192, MISC_OFF = LDSCTL_OFF + 320;
constexpr int LDS_BYTES = 147456;
constexpr int G_TOT = 0, G_QT = 2048, G_KT = 12288, G_VT = 24576, G_ST = 45056, G_OST = 65536, G_UT = 45056;
constexpr int QK_STRIDE = 144, KD_STRIDE = 192, V_STRIDE = 320, OST_STRIDE = 528, U_STRIDE = 272;

#define GAS __attribute__((address_space(1)))
#define LAS __attribute__((address_space(3)))
typedef unsigned short bf16;
typedef unsigned v4u __attribute__((ext_vector_type(4)));
typedef unsigned v2u __attribute__((ext_vector_type(2)));
typedef float f32x4 __attribute__((ext_vector_type(4)));
typedef float f32x16 __attribute__((ext_vector_type(16)));
typedef short bf16x8 __attribute__((ext_vector_type(8)));
typedef short s16x4 __attribute__((ext_vector_type(4)));
typedef GAS unsigned gu32;
#define RLX_AGENT __ATOMIC_RELAXED, __HIP_MEMORY_SCOPE_AGENT
#define LDS_WAIT() asm volatile("s_waitcnt lgkmcnt(0)" ::: "memory")
#define VM_WAIT() asm volatile("s_waitcnt vmcnt(0)" ::: "memory")
using pg8::cvt_pk_bf16; using pg8::fast_exp; using pg8::fast_rcp; using pg8::siluf_;
__device__ __forceinline__ float bf_lo(unsigned w) { return __uint_as_float(w << 16); }
__device__ __forceinline__ float bf_hi(unsigned w) { return __uint_as_float(w & 0xffff0000u); }
__device__ __forceinline__ void unpack8(const v4u& w, float (&f)[8]) { f[0] = bf_lo(w.x); f[1] = bf_hi(w.x); f[2] = bf_lo(w.y); f[3] = bf_hi(w.y); f[4] = bf_lo(w.z); f[5] = bf_hi(w.z); f[6] = bf_lo(w.w); f[7] = bf_hi(w.w); }
__device__ __forceinline__ v4u pack8(const float (&f)[8]) { v4u w; w.x = cvt_pk_bf16(f[0], f[1]); w.y = cvt_pk_bf16(f[2], f[3]); w.z = cvt_pk_bf16(f[4], f[5]); w.w = cvt_pk_bf16(f[6], f[7]); return w; }
#define XB_TMO      128
#define XB_XCNT(j)  (256  + 64 * (j))
#define XB_XSUB(j)  (1280 + 64 * (j))
#define XB_XGEN(j)  (2304 + 64 * (j))
#define XB_TOP      3328
#define XB_TOPGEN   3392
#define XCD_BAR_WORDS 3456
#define XB_SPIN_CAP (1u << 18)

__device__ __forceinline__ unsigned xb_ld(unsigned* p)              { return __hip_atomic_load(p, __ATOMIC_RELAXED, __HIP_MEMORY_SCOPE_AGENT); }
__device__ __forceinline__ unsigned xb_add(unsigned* p, unsigned v) { return __hip_atomic_fetch_add(p, v, __ATOMIC_RELAXED, __HIP_MEMORY_SCOPE_AGENT); }
__device__ __forceinline__ unsigned xb_xcc_id() { return (unsigned)__builtin_amdgcn_s_getreg((3 << 11) | 20) & 0xFu; }
#define XB_SPIN(cond, bar) do { unsigned _sp = 0; while (cond) { __builtin_amdgcn_s_sleep(1); \
    if ((++_sp & 255u) == 0u) { if (xb_ld(&(bar)[XB_TMO])) break; if (_sp > XB_SPIN_CAP) { atomicAdd(&(bar)[XB_TMO], 1u); break; } } } } while (0)

struct XcdBarrier {
    unsigned* bar; unsigned x;
    volatile LAS unsigned* st;
};

__device__ __forceinline__ XcdBarrier xcd_barrier_post(unsigned* bar, volatile LAS unsigned* st) {
    XcdBarrier b; b.bar = bar; b.x = xb_xcc_id(); b.st = st;
    if (threadIdx.x == 0) (void)xb_add(&bar[XB_XCNT(b.x)], 1u);
    return b;
}
__device__ __forceinline__ void xcd_barrier_complete(unsigned* bar, unsigned x, unsigned& nloc, unsigned& nx) {
    const unsigned G = gridDim.x * gridDim.y * gridDim.z;
    unsigned sum, cnt, mine, sp = 0u;
    for (;;) {
        sum = 0u; cnt = 0u; mine = 0u;
#pragma unroll
        for (unsigned j = 0; j < 16; ++j) { const unsigned c = xb_ld(&bar[XB_XCNT(j)]); sum += c; cnt += (c > 0u) ? 1u : 0u; mine = (j == x) ? c : mine; }
        if (sum == G) break;
        __builtin_amdgcn_s_sleep(1);
        if ((++sp & 255u) == 0u) { if (xb_ld(&bar[XB_TMO])) break; if (sp > XB_SPIN_CAP) { atomicAdd(&bar[XB_TMO], 1u); break; } }
    }
    nloc = mine > 0u ? mine : 1u; nx = cnt > 0u ? cnt : 1u;
}

__device__ __forceinline__ void xcd_barrier(const XcdBarrier& b) {
    asm volatile("s_waitcnt vmcnt(0)" ::: "memory");
    __syncthreads();
    if (threadIdx.x == 0) {
        unsigned* bar = b.bar;
        __builtin_amdgcn_s_waitcnt(0);
        unsigned nloc = b.st[0], nx = b.st[1];
        if (nloc == 0u) { xcd_barrier_complete(bar, b.x, nloc, nx); b.st[0] = nloc; b.st[1] = nx; }
        const unsigned old = xb_add(&bar[XB_XSUB(b.x)], 1u);
        const unsigned gen = old / nloc;
        if (old + 1u == (gen + 1u) * nloc) {
            __builtin_amdgcn_fence(__ATOMIC_RELEASE, "agent");
            asm volatile("s_waitcnt vmcnt(0)" ::: "memory");
            const unsigned og = xb_add(&bar[XB_TOP], 1u);
            const unsigned tg = og / nx;
            if (og + 1u == (tg + 1u) * nx) xb_add(&bar[XB_TOPGEN], 1u);
            else XB_SPIN(xb_ld(&bar[XB_TOPGEN]) == tg, bar);
            __builtin_amdgcn_fence(__ATOMIC_ACQUIRE, "agent");
            xb_add(&bar[XB_XGEN(b.x)], 1u);
            asm volatile("s_waitcnt vmcnt(0)" ::: "memory");
        } else {
            XB_SPIN(xb_ld(&bar[XB_XGEN(b.x)]) == gen, bar);
            __builtin_amdgcn_fence(__ATOMIC_ACQUIRE, "agent");
            asm volatile("s_waitcnt vmcnt(0)" ::: "memory");
        }
    }
    __syncthreads();
}

struct Args { const float* in[16]; float* out; unsigned char* ws; int ph_lo, ph_hi; };
struct Frame {
    LAS unsigned char* lds;
    gu32* ctl;
    int tid, lane, wave;
    int G;
    const __attribute__((address_space(4))) Args* ap;
    GAS float* out; GAS unsigned char* ws;
};
__device__ __forceinline__ GAS bf16* w_ptr(const Frame& F, int L, size_t off) { return (GAS bf16*)(F.ws + WS_W + (size_t)L * W_LAYER + off); }
__device__ __forceinline__ float wave_sum(float v) {
#pragma unroll
    for (int o = 1; o < 64; o <<= 1) v += __shfl_xor(v, o);
    return v;
}
__device__ __forceinline__ s16x4 tr_read(LAS unsigned char* p) { typedef short v4i16_t __attribute__((ext_vector_type(4))); return __builtin_bit_cast(s16x4, __builtin_amdgcn_ds_read_tr16_b64_v4i16((LAS v4i16_t*)p)); }
__device__ __forceinline__ bf16x8 cat8(s16x4 lo, s16x4 hi) { return (bf16x8){lo[0], lo[1], lo[2], lo[3], hi[0], hi[1], hi[2], hi[3]}; }

struct TDesc { const GAS float* src; const GAS float* gk; GAS bf16* dst; int ldw, K; float cmul; };
constexpr int I_IN = 16 * 96, I_OUT = 16 * 32, I_GU = 16 * 176, I_DN = 44 * 32, I_PG = 16 * 32, I_PP = 4 * 32, I_LAYER = I_IN + I_OUT + I_GU + I_DN + I_PG + I_PP;
__device__ __forceinline__ TDesc tr_decode(const Frame& F, int it) {
    const int L = it / I_LAYER; int r = it % I_LAYER; TDesc d;
    if (r < I_IN) { const int kb = r / 96, nb = r % 96, n0 = 32 * nb, k0 = 64 * kb;
        const int sc = n0 < 1536 ? n0 : (n0 < 2048 ? n0 + 16 : ((((n0 - 2048) >> 7) & 1) ? 2576 : 2064) + 128 * ((n0 - 2048) >> 8) + ((n0 - 2048) & 127));
        d.src = ((const GAS float*)F.ap->in[3]) + (size_t)L * DM * IN_DIM + (size_t)k0 * IN_DIM + sc; d.gk = ((const GAS float*)F.ap->in[2]) + L * DM + k0; d.dst = w_ptr(F, L, WO_IN) + (size_t)n0 * 1024 + k0;
        d.ldw = IN_DIM; d.K = 1024; d.cmul = n0 < 256 ? 0.125f : 1.0f; return d; } r -= I_IN;
    if (r < I_OUT) { const int kb = r / 32, nb = r % 32, k0 = 64 * kb;
        d.src = ((const GAS float*)F.ap->in[8]) + (size_t)L * 1024 * 1024 + (size_t)k0 * 1024 + 32 * nb; d.gk = nullptr; d.dst = w_ptr(F, L, WO_OUT) + (size_t)(32 * nb) * 1024 + k0;
        d.ldw = 1024; d.K = 1024; d.cmul = 1.0f; return d; } r -= I_OUT;
    if (r < I_GU) { const int kb = r / 176, nb = r % 176, n0 = 32 * nb, pn = n0 >> 8, bj = (n0 >> 7) & 1, sc = bj * FFN + 128 * pn + (n0 & 127), k0 = 64 * kb;
        d.src = ((const GAS float*)F.ap->in[10]) + (size_t)L * DM * 2 * FFN + (size_t)k0 * 2 * FFN + sc; d.gk = ((const GAS float*)F.ap->in[9]) + L * DM + k0; d.dst = w_ptr(F, L, WO_GU) + (size_t)n0 * 1024 + k0;
        d.ldw = 2 * FFN; d.K = 1024; d.cmul = 1.0f; return d; } r -= I_GU;
    if (r < I_DN) { const int kb = r / 32, nb = r % 32, k0 = 64 * kb;
        d.src = ((const GAS float*)F.ap->in[11]) + (size_t)L * FFN * DM + (size_t)k0 * DM + 32 * nb; d.gk = nullptr; d.dst = w_ptr(F, L, WO_DN) + (size_t)(32 * nb) * FFN + k0;
        d.ldw = DM; d.K = FFN; d.cmul = 1.0f; return d; } r -= I_DN;
    if (r < I_PG) { const int kb = r / 32, nb = r % 32, k0 = 64 * kb;
        d.src = ((const GAS float*)F.ap->in[13]) + (size_t)L * DM * DM + (size_t)k0 * DM + 32 * nb; d.gk = ((const GAS float*)F.ap->in[12]) + L * DM + k0; d.dst = w_ptr(F, L, WO_PG) + (size_t)(32 * nb) * 1024 + k0;
        d.ldw = DM; d.K = 1024; d.cmul = 1.0f; return d; } r -= I_PG;
    { const int kb = r / 32, nb = r % 32, k0 = 64 * kb;
        d.src = ((const GAS float*)F.ap->in[14]) + (size_t)L * PLE * DM + (size_t)k0 * DM + 32 * nb; d.gk = nullptr; d.dst = w_ptr(F, L, WO_PP) + (size_t)(32 * nb) * PLE + k0;
        d.ldw = DM; d.K = PLE; d.cmul = 1.0f; return d; }
}
struct TRegs { f32x4 v[8]; float g[8]; };
__device__ __forceinline__ void tr_load(const TDesc& d, TRegs& R, int lane) {
#pragma unroll
    for (int j = 0; j < 8; ++j) { const int kk = (lane >> 3) + 8 * j; R.v[j] = *(const GAS f32x4*)(d.src + (size_t)kk * d.ldw + 4 * (lane & 7)); R.g[j] = d.gk ? d.gk[kk] : 1.0f; }
}
__device__ __forceinline__ void tr_process(const TDesc& d, const TRegs& R, LAS float* scr, int lane) {
#pragma unroll
    for (int j = 0; j < 8; ++j) { const int kk = (lane >> 3) + 8 * j; const float s = R.g[j] * d.cmul; LAS float* w = scr + kk * 33 + 4 * (lane & 7);
        w[0] = R.v[j][0] * s; w[1] = R.v[j][1] * s; w[2] = R.v[j][2] * s; w[3] = R.v[j][3] * s; }
    LDS_WAIT(); asm volatile("" ::: "memory");
    const int c = lane & 7;
#pragma unroll
    for (int j = 0; j < 4; ++j) { const int n = (lane >> 3) + 8 * j; const LAS float* s = scr + (8 * c) * 33 + n;
        v4u o; o.x = cvt_pk_bf16(s[0 * 33], s[1 * 33]); o.y = cvt_pk_bf16(s[2 * 33], s[3 * 33]); o.z = cvt_pk_bf16(s[4 * 33], s[5 * 33]); o.w = cvt_pk_bf16(s[6 * 33], s[7 * 33]);
        *(GAS v4u*)(d.dst + (size_t)n * d.K + 8 * c) = o; }
    LDS_WAIT(); asm volatile("" ::: "memory");
}
__device__ __forceinline__ void p0_prologue(Frame& F) {
    LAS float* scr = (LAS float*)(F.lds + RING_OFF + F.wave * 16384);
    const int gw = blockIdx.x * NWAVES + F.wave, NGW = F.G * NWAVES;
    { int it = gw; TDesc d; TRegs R;
      if (it < DEPTH * I_LAYER) { d = tr_decode(F, it); tr_load(d, R, F.lane); }
      while (it < DEPTH * I_LAYER) { const int itn = it + NGW; TDesc dn = d; TRegs Rn = R;
          if (itn < DEPTH * I_LAYER) { dn = tr_decode(F, itn); tr_load(dn, Rn, F.lane); }
          tr_process(d, R, scr, F.lane); d = dn; R = Rn; it = itn; } }
    const int gt = blockIdx.x * (NWAVES * 64) + F.tid, NGT = F.G * NWAVES * 64;
    for (int it = gt; it < DEPTH * 256 * 128; it += NGT) {
        const int L = it >> 15, r = it & 32767, n = r >> 7, k0 = (r & 127) * 8;
        const GAS float* win = ((const GAS float*)F.ap->in[3]) + (size_t)L * DM * IN_DIM; const GAS float* wgu = ((const GAS float*)F.ap->in[4]) + (size_t)L * 16 * 256 + n; const GAS float* g1 = ((const GAS float*)F.ap->in[2]) + L * DM;
        float wg[16];
#pragma unroll
        for (int rr = 0; rr < 16; ++rr) wg[rr] = wgu[rr * 256];
        float o[8];
#pragma unroll
        for (int kk = 0; kk < 8; ++kk) { const GAS f32x4* wr_ = (const GAS f32x4*)(win + (size_t)(k0 + kk) * IN_DIM + 1536); float s = 0.f;
#pragma unroll
            for (int rr = 0; rr < 4; ++rr) { const f32x4 w4 = wr_[rr]; s += (w4[0] * wg[4 * rr] + w4[1] * wg[4 * rr + 1]) + (w4[2] * wg[4 * rr + 2] + w4[3] * wg[4 * rr + 3]); }
            o[kk] = s * g1[k0 + kk]; }
        *(GAS v4u*)(w_ptr(F, L, WO_IN) + (size_t)(3072 + n) * 1024 + k0) = pack8(o);
    }
    GAS bf16* HB = (GAS bf16*)(F.ws + WS_HB); GAS float* SSQ0 = (GAS float*)(F.ws + WS_SSQ0);
    for (int m = 2 * gw; m < M; m += 2 * NGW) {
        f32x4 v[2][4]; float s[2] = {0.f, 0.f};
#pragma unroll
        for (int rr = 0; rr < 2; ++rr) { const GAS f32x4* xr = (const GAS f32x4*)(((const GAS float*)F.ap->in[0]) + (size_t)(m + rr) * DM) + F.lane;
#pragma unroll
            for (int j = 0; j < 4; ++j) v[rr][j] = xr[64 * j]; }
#pragma unroll
        for (int rr = 0; rr < 2; ++rr) {
#pragma unroll
            for (int j = 0; j < 4; ++j) s[rr] += (v[rr][j][0] * v[rr][j][0] + v[rr][j][1] * v[rr][j][1]) + (v[rr][j][2] * v[rr][j][2] + v[rr][j][3] * v[rr][j][3]);
            s[rr] = wave_sum(s[rr]);
            GAS v2u* o8 = (GAS v2u*)(HB + (size_t)(m + rr) * DM) + F.lane;
#pragma unroll
            for (int j = 0; j < 4; ++j) { v2u w; w.x = cvt_pk_bf16(v[rr][j][0], v[rr][j][1]); w.y = cvt_pk_bf16(v[rr][j][2], v[rr][j][3]); o8[64 * j] = w; }
            if (F.lane == 0) *(GAS f32x4*)(SSQ0 + (size_t)(m + rr) * 4) = (f32x4){s[rr], 0.f, 0.f, 0.f}; }
    }
    GAS bf16* PB = (GAS bf16*)(F.ws + WS_PB);
    constexpr size_t NP8 = (size_t)DEPTH * M * PLE / 8;
    for (size_t i = (size_t)gt; i < NP8; i += 4 * (size_t)NGT) {
        f32x4 a[4], b[4];
#pragma unroll
        for (int u = 0; u < 4; ++u) { const size_t ii = i + (size_t)u * NGT; if (ii < NP8) { const GAS f32x4* s = (const GAS f32x4*)(F.ap->in[1]) + 2 * ii; a[u] = s[0]; b[u] = s[1]; } }
#pragma unroll
        for (int u = 0; u < 4; ++u) { const size_t ii = i + (size_t)u * NGT; if (ii < NP8) {
            v4u w; w.x = cvt_pk_bf16(a[u][0], a[u][1]); w.y = cvt_pk_bf16(a[u][2], a[u][3]); w.z = cvt_pk_bf16(b[u][0], b[u][1]); w.w = cvt_pk_bf16(b[u][2], b[u][3]);
            *((GAS v4u*)PB + ii) = w; } }
    }
}

__device__ __forceinline__ void gla_prefix(const v4u& la, LAS unsigned char* lds, int wid, int lane, float (&bc)[8], float (&tot)[8]) {
    float c[8]; unpack8(la, c);
#pragma unroll
    for (int off = 8; off < 64; off <<= 1)
#pragma unroll
        for (int j = 0; j < 8; ++j) { const float v = __shfl_up(c[j], off); if (lane >= off) c[j] += v; }
    LAS float* T = (LAS float*)(lds + G_TOT);
    const int d0 = 8 * (lane & 7);
    if (lane >= 56) { *(LAS f32x4*)(T + wid * 64 + d0) = (f32x4){c[0], c[1], c[2], c[3]}; *(LAS f32x4*)(T + wid * 64 + d0 + 4) = (f32x4){c[4], c[5], c[6], c[7]}; }
    LDS_WAIT(); __syncthreads();
    float off[8];
#pragma unroll
    for (int j = 0; j < 8; ++j) { off[j] = 0.f; tot[j] = 0.f; }
#pragma unroll
    for (int w = 0; w < 8; ++w) { const f32x4 a = *(LAS f32x4*)(T + w * 64 + d0), b = *(LAS f32x4*)(T + w * 64 + d0 + 4);
        const float tv[8] = {a[0], a[1], a[2], a[3], b[0], b[1], b[2], b[3]};
#pragma unroll
        for (int j = 0; j < 8; ++j) { tot[j] += tv[j]; if (w < wid) off[j] += tv[j]; } }
#pragma unroll
    for (int j = 0; j < 8; ++j) bc[j] = off[j] + c[j];
}

struct P1Regs { v4u la, kk, vv[2]; };
__device__ __forceinline__ void p1_load(P1Regs& R, const GAS bf16* PROJ, int item, int t, int d0, int tid) {
    const int bh = item >> 7, n = item & 127, b = bh >> 2, h = bh & 3; const size_t tok0 = (size_t)b * SEQ + (size_t)n * CHUNK;
    const GAS bf16* row = PROJ + (tok0 + t) * PS;
    R.la = *(const GAS v4u*)(row + PC_LA + 64 * h + d0);
    R.kk = *(const GAS v4u*)(row + PC_K + 64 * h + d0);
#pragma unroll
    for (int i = 0; i < 2; ++i) R.vv[i] = *(const GAS v4u*)(PROJ + (tok0 + 32 * i + (tid >> 4)) * PS + PC_V + 128 * h + 8 * (tid & 15));
}
__device__ __forceinline__ void gla_p1(Frame& F, int L) {
    const GAS bf16* PROJ = (const GAS bf16*)(F.ws + WS_PROJ); GAS bf16* U = (GAS bf16*)(F.ws + WS_UB); GAS float* DEC = (GAS float*)(F.ws + WS_DECAY);
    LAS unsigned char* lds = F.lds + RING_OFF; const int wid = F.wave, lane = F.lane, tid = F.tid;
    const int t = 8 * wid + (lane >> 3), d0 = 8 * (lane & 7);
    const int r = lane & 31, hh = lane >> 5, g1 = (lane >> 4) & 1, q = (lane & 15) >> 2, p = lane & 3;
    const int dkt = wid >> 2, dvt = wid & 3;
    P1Regs R;
    if ((int)blockIdx.x < NITEM) p1_load(R, PROJ, blockIdx.x, t, d0, tid);
    for (int item = blockIdx.x; item < NITEM; item += F.G) {
#pragma unroll
        for (int i = 0; i < 2; ++i) *(LAS v4u*)(lds + G_VT + (32 * i + (tid >> 4)) * V_STRIDE + (tid & 15) * 16) = R.vv[i];
        float bc[8], tot[8]; gla_prefix(R.la, lds, wid, lane, bc, tot);
        float kf[8]; unpack8(R.kk, kf);
#pragma unroll
        for (int j = 0; j < 8; ++j) kf[j] *= fast_exp(tot[j] - bc[j]);
        *(LAS v4u*)(lds + G_KT + t * KD_STRIDE + d0 * 2) = pack8(kf);
        if (tid < 8) { GAS f32x4* dp = (GAS f32x4*)(DEC + (size_t)item * 64 + d0); dp[0] = (f32x4){fast_exp(tot[0]), fast_exp(tot[1]), fast_exp(tot[2]), fast_exp(tot[3])}; dp[1] = (f32x4){fast_exp(tot[4]), fast_exp(tot[5]), fast_exp(tot[6]), fast_exp(tot[7])}; }
        if (item + F.G < NITEM) p1_load(R, PROJ, item + F.G, t, d0, tid);
        LDS_WAIT(); __syncthreads();
        f32x16 acc;
#pragma unroll
        for (int i = 0; i < 16; ++i) acc[i] = 0.f;
#pragma unroll
        for (int ks = 0; ks < 4; ++ks) { const int rw = 16 * ks + 8 * hh + q;
            LAS unsigned char* ap = lds + G_KT + rw * KD_STRIDE + (32 * dkt + 16 * g1 + 4 * p) * 2;
            LAS unsigned char* bp = lds + G_VT + rw * V_STRIDE + (32 * dvt + 16 * g1 + 4 * p) * 2;
            const bf16x8 a = cat8(tr_read(ap), tr_read(ap + 4 * KD_STRIDE)), bb = cat8(tr_read(bp), tr_read(bp + 4 * V_STRIDE));
            acc = __builtin_amdgcn_mfma_f32_32x32x16_bf16(a, bb, acc, 0, 0, 0); }
        { LAS unsigned short* up = (LAS unsigned short*)(lds + G_UT + (32 * dkt + 4 * hh) * U_STRIDE) + 32 * dvt + r;
#pragma unroll
          for (int i = 0; i < 16; i += 2) { const unsigned w = cvt_pk_bf16(acc[i], acc[i + 1]);
              up[((i & 3) + 8 * (i >> 2)) * (U_STRIDE / 2)] = (unsigned short)(w & 0xffffu); up[(((i + 1) & 3) + 8 * ((i + 1) >> 2)) * (U_STRIDE / 2)] = (unsigned short)(w >> 16); } }
        LDS_WAIT(); __syncthreads();
        { const int row = tid >> 3, sg = tid & 7; const LAS v4u* sp = (const LAS v4u*)(lds + G_UT + row * U_STRIDE + sg * 32); const v4u a = sp[0], b2 = sp[1];
          GAS v4u* gp = (GAS v4u*)(U + (size_t)item * 8192 + row * 128 + sg * 16); gp[0] = a; gp[1] = b2; }
    }
}

__device__ __forceinline__ void gla_p2(Frame& F, int L) {
    if (F.wave < 4) {
        const GAS unsigned* U = (const GAS unsigned*)(F.ws + WS_UB); const GAS float* DEC = (const GAS float*)(F.ws + WS_DECAY); GAS unsigned* S = (GAS unsigned*)(F.ws + WS_S);
        for (int e = blockIdx.x * 256 + F.tid; e < BATCH * NH * 4096; e += F.G * 256) {
            const int bh = e >> 12, idx = e & 4095, dk = idx >> 6;
            const GAS unsigned* Up = U + (size_t)bh * NCH * 4096 + idx; const GAS float* dp = DEC + (size_t)bh * NCH * 64 + dk; GAS unsigned* Sp = S + (size_t)bh * NCH * 4096 + idx;
            float s0 = 0.f, s1 = 0.f;
            for (int n0 = 0; n0 < NCH; n0 += 16) {
                unsigned u[16]; float d[16];
#pragma unroll
                for (int i = 0; i < 16; ++i) { u[i] = Up[(size_t)(n0 + i) * 4096]; d[i] = dp[(n0 + i) * 64]; }
#pragma unroll
                for (int i = 0; i < 16; ++i) { Sp[(size_t)(n0 + i) * 4096] = cvt_pk_bf16(s0, s1); s0 = d[i] * s0 + bf_lo(u[i]); s1 = d[i] * s1 + bf_hi(u[i]); }
            }
        }
    } else {
        const GAS bf16* PROJ = (const GAS bf16*)(F.ws + WS_PROJ); GAS bf16* MIX = (GAS bf16*)(F.ws + WS_U);
        const GAS float* cw = ((const GAS float*)F.ap->in[6]) + (size_t)L * 3 * CONVD;
        const int t2 = F.tid - 256, c = 8 * (t2 & 63), tq = t2 >> 6;
        float w0[8], w1[8], w2[8];
        { const f32x4 a = *(const GAS f32x4*)(cw + c), b2 = *(const GAS f32x4*)(cw + c + 4); w0[0] = a[0]; w0[1] = a[1]; w0[2] = a[2]; w0[3] = a[3]; w0[4] = b2[0]; w0[5] = b2[1]; w0[6] = b2[2]; w0[7] = b2[3]; }
        { const f32x4 a = *(const GAS f32x4*)(cw + CONVD + c), b2 = *(const GAS f32x4*)(cw + CONVD + c + 4); w1[0] = a[0]; w1[1] = a[1]; w1[2] = a[2]; w1[3] = a[3]; w1[4] = b2[0]; w1[5] = b2[1]; w1[6] = b2[2]; w1[7] = b2[3]; }
        { const f32x4 a = *(const GAS f32x4*)(cw + 2 * CONVD + c), b2 = *(const GAS f32x4*)(cw + 2 * CONVD + c + 4); w2[0] = a[0]; w2[1] = a[1]; w2[2] = a[2]; w2[3] = a[3]; w2[4] = b2[0]; w2[5] = b2[1]; w2[6] = b2[2]; w2[7] = b2[3]; }
        for (int blk = blockIdx.x; blk < M / 128; blk += F.G) {
            const size_t m0 = (size_t)blk * 128 + 32 * tq;
            float u1[8], u2[8];
            if ((m0 & (SEQ - 1)) == 0) {
#pragma unroll
                for (int j = 0; j < 8; ++j) { u1[j] = 0.f; u2[j] = 0.f; }
            } else {
                const v4u a1 = *(const GAS v4u*)(PROJ + (m0 - 1) * PS + PC_U + c), a2 = *(const GAS v4u*)(PROJ + (m0 - 2) * PS + PC_U + c);
                unpack8(a1, u1); unpack8(a2, u2);
            }
            for (int g0 = 0; g0 < 32; g0 += 8) {
                v4u wu[8], wb[8];
#pragma unroll
                for (int i = 0; i < 8; ++i) { const GAS bf16* rp = PROJ + (m0 + g0 + i) * PS; wu[i] = *(const GAS v4u*)(rp + PC_U + c); wb[i] = *(const GAS v4u*)(rp + PC_CB + c); }
#pragma unroll
                for (int i = 0; i < 8; ++i) { float fu[8], fb[8], y[8]; unpack8(wu[i], fu); unpack8(wb[i], fb);
#pragma unroll
                    for (int j = 0; j < 8; ++j) { const float u0 = fu[j]; y[j] = fb[j] * (w0[j] * u2[j] + w1[j] * u1[j] + w2[j] * u0); u2[j] = u1[j]; u1[j] = u0; }
                    *(GAS v4u*)(MIX + (m0 + g0 + i) * 1024 + 512 + c) = pack8(y); }
            }
        }
    }
}

struct P3Regs { v4u la, qq, kk, vv[2], ss[2], gw[2]; };
__device__ __forceinline__ void p3_load(P3Regs& R, const GAS bf16* PROJ, const GAS bf16* S, int item, int t, int d0, int tid) {
    const int bh = item >> 7, n = item & 127, b = bh >> 2, h = bh & 3; const size_t tok0 = (size_t)b * SEQ + (size_t)n * CHUNK;
    const GAS bf16* row = PROJ + (tok0 + t) * PS;
    R.la = *(const GAS v4u*)(row + PC_LA + 64 * h + d0);
    R.qq = *(const GAS v4u*)(row + PC_Q + 64 * h + d0);
    R.kk = *(const GAS v4u*)(row + PC_K + 64 * h + d0);
#pragma unroll
    for (int i = 0; i < 2; ++i) { R.vv[i] = *(const GAS v4u*)(PROJ + (tok0 + 32 * i + (tid >> 4)) * PS + PC_V + 128 * h + 8 * (tid & 15));
                                  R.ss[i] = *(const GAS v4u*)(S + (size_t)item * 8192 + (size_t)(32 * i + (tid >> 4)) * 128 + 8 * (tid & 15)); }
    const GAS bf16* grow = PROJ + (tok0 + (tid >> 3)) * PS + PC_G + 128 * h + 16 * (tid & 7);
    R.gw[0] = *(const GAS v4u*)(grow); R.gw[1] = *(const GAS v4u*)(grow + 8);
}
__device__ __forceinline__ void gla_p3(Frame& F, int L) {
    const GAS bf16* PROJ = (const GAS bf16*)(F.ws + WS_PROJ); const GAS bf16* S = (const GAS bf16*)(F.ws + WS_S); GAS bf16* MIX = (GAS bf16*)(F.ws + WS_U);
    const GAS float* gn = ((const GAS float*)F.ap->in[7]) + L * DV;
    LAS unsigned char* lds = F.lds + RING_OFF; const int wid = F.wave, lane = F.lane, tid = F.tid;
    const int t = 8 * wid + (lane >> 3), d0 = 8 * (lane & 7);
    const int r = lane & 31, hh = lane >> 5, g1 = (lane >> 4) & 1, q = (lane & 15) >> 2, p = lane & 3;
    const int tt = wid >> 2, dvt = wid & 3;
    f32x4 gnv[4];
#pragma unroll
    for (int i = 0; i < 4; ++i) gnv[i] = *(const GAS f32x4*)(gn + 16 * (tid & 7) + 4 * i);
    P3Regs R;
    if ((int)blockIdx.x < NITEM) p3_load(R, PROJ, S, blockIdx.x, t, d0, tid);
    for (int item = blockIdx.x; item < NITEM; item += F.G) {
        const int bh = item >> 7, n = item & 127, b = bh >> 2, h = bh & 3; const size_t tok0 = (size_t)b * SEQ + (size_t)n * CHUNK;
#pragma unroll
        for (int i = 0; i < 2; ++i) { *(LAS v4u*)(lds + G_VT + (32 * i + (tid >> 4)) * V_STRIDE + (tid & 15) * 16) = R.vv[i];
                                      *(LAS v4u*)(lds + G_ST + (32 * i + (tid >> 4)) * V_STRIDE + (tid & 15) * 16) = R.ss[i]; }
        float bc[8], tot[8]; gla_prefix(R.la, lds, wid, lane, bc, tot);
        { float qf[8], kf[8]; unpack8(R.qq, qf); unpack8(R.kk, kf);
#pragma unroll
          for (int j = 0; j < 8; ++j) { const float e = fast_exp(bc[j]); qf[j] *= e; kf[j] *= fast_rcp(e); }
          *(LAS v4u*)(lds + G_QT + t * QK_STRIDE + d0 * 2) = pack8(qf);
          *(LAS v4u*)(lds + G_KT + t * QK_STRIDE + d0 * 2) = pack8(kf); }
        const v4u gw0 = R.gw[0], gw1 = R.gw[1];
        if (item + F.G < NITEM) p3_load(R, PROJ, S, item + F.G, t, d0, tid);
        LDS_WAIT(); __syncthreads();
        f32x16 o;
#pragma unroll
        for (int i = 0; i < 16; ++i) o[i] = 0.f;
        bf16x8 qfr[4];
#pragma unroll
        for (int ks = 0; ks < 4; ++ks) qfr[ks] = *(LAS bf16x8*)(lds + G_QT + (32 * tt + r) * QK_STRIDE + (16 * ks + 8 * hh) * 2);
#pragma unroll
        for (int ks = 0; ks < 4; ++ks) { LAS unsigned char* bp = lds + G_ST + (16 * ks + 8 * hh + q) * V_STRIDE + (32 * dvt + 16 * g1 + 4 * p) * 2;
            const bf16x8 sb = cat8(tr_read(bp), tr_read(bp + 4 * V_STRIDE));
            o = __builtin_amdgcn_mfma_f32_32x32x16_bf16(qfr[ks], sb, o, 0, 0, 0); }
        for (int st = 0; st <= tt; ++st) {
            f32x16 x;
#pragma unroll
            for (int i = 0; i < 16; ++i) x[i] = 0.f;
#pragma unroll
            for (int ks = 0; ks < 4; ++ks) { const bf16x8 ka = *(LAS bf16x8*)(lds + G_KT + (32 * st + r) * QK_STRIDE + (16 * ks + 8 * hh) * 2);
                x = __builtin_amdgcn_mfma_f32_32x32x16_bf16(ka, qfr[ks], x, 0, 0, 0); }
            if (st == tt) {
#pragma unroll
                for (int i = 0; i < 16; ++i) { const int sl = (i & 3) + 8 * (i >> 2) + 4 * hh; if (sl > r) x[i] = 0.f; } }
#pragma unroll
            for (int k2 = 0; k2 < 2; ++k2) {
                v4u pw; pw.x = cvt_pk_bf16(x[8 * k2 + 0], x[8 * k2 + 1]); pw.y = cvt_pk_bf16(x[8 * k2 + 2], x[8 * k2 + 3]); pw.z = cvt_pk_bf16(x[8 * k2 + 4], x[8 * k2 + 5]); pw.w = cvt_pk_bf16(x[8 * k2 + 6], x[8 * k2 + 7]);
                LAS unsigned char* bp = lds + G_VT + (32 * st + 16 * k2 + 4 * hh + q) * V_STRIDE + (32 * dvt + 16 * g1 + 4 * p) * 2;
                const bf16x8 vb = cat8(tr_read(bp), tr_read(bp + 8 * V_STRIDE));
                o = __builtin_amdgcn_mfma_f32_32x32x16_bf16(__builtin_bit_cast(bf16x8, pw), vb, o, 0, 0, 0); }
        }
        { LAS float* op = (LAS float*)(lds + G_OST + (32 * tt + 4 * hh) * OST_STRIDE) + 32 * dvt + r;
#pragma unroll
          for (int i = 0; i < 16; ++i) op[((i & 3) + 8 * (i >> 2)) * (OST_STRIDE / 4)] = o[i]; }
        LDS_WAIT(); __syncthreads();
        { const int trw = tid >> 3, sg = tid & 7; const LAS f32x4* op = (const LAS f32x4*)(lds + G_OST + trw * OST_STRIDE + sg * 64);
          f32x4 ov[4]; float ssq = 0.f;
#pragma unroll
          for (int i = 0; i < 4; ++i) { ov[i] = op[i]; ssq += (ov[i][0] * ov[i][0] + ov[i][1] * ov[i][1]) + (ov[i][2] * ov[i][2] + ov[i][3] * ov[i][3]); }
          ssq += __shfl_xor(ssq, 1); ssq += __shfl_xor(ssq, 2); ssq += __shfl_xor(ssq, 4);
          const float rs = __builtin_amdgcn_rsqf(ssq * (1.0f / DV) + pg8::RMS_EPS);
          float gf[16]; { float a8[8]; unpack8(gw0, a8);
#pragma unroll
              for (int j = 0; j < 8; ++j) gf[j] = a8[j];
              unpack8(gw1, a8);
#pragma unroll
              for (int j = 0; j < 8; ++j) gf[8 + j] = a8[j]; }
          float res[16];
#pragma unroll
          for (int i = 0; i < 4; ++i)
#pragma unroll
              for (int j = 0; j < 4; ++j) res[4 * i + j] = ov[i][j] * rs * gnv[i][j] * siluf_(gf[4 * i + j]);
          GAS bf16* mrow = MIX + (tok0 + trw) * 1024 + 128 * h + 16 * sg;
          { float a8[8];
#pragma unroll
            for (int j = 0; j < 8; ++j) a8[j] = res[j];
            *(GAS v4u*)(mrow) = pack8(a8);
#pragma unroll
            for (int j = 0; j < 8; ++j) a8[j] = res[8 + j];
            *(GAS v4u*)(mrow + 8) = pack8(a8); } }
    }
}

__device__ __forceinline__ void final_norm(Frame& F, const GAS float* ssq) {
    const int gw = blockIdx.x * NWAVES + F.wave, NGW = F.G * NWAVES;
    static_assert((DEPTH & 1) == 0, "the final residual stream must sit in d_ws (buffer 0), not in d_out");
    const GAS bf16* HB = (const GAS bf16*)(F.ws + WS_HB);
    f32x4 gv[4];
#pragma unroll
    for (int j = 0; j < 2; ++j) { gv[2 * j] = *((const GAS f32x4*)(((const GAS float*)F.ap->in[15]) + 512 * j + 8 * F.lane)); gv[2 * j + 1] = *((const GAS f32x4*)(((const GAS float*)F.ap->in[15]) + 512 * j + 8 * F.lane + 4)); }
    for (int m = gw; m < M; m += NGW) {
        const float rs = pg8::rstd_from(ssq, m);
        const GAS bf16* hr = HB + (size_t)m * DM + 8 * F.lane; GAS float* orow = F.out + (size_t)m * DM + 8 * F.lane;
#pragma unroll
        for (int j = 0; j < 2; ++j) { const v4u w = *(const GAS v4u*)(hr + 512 * j); float f[8]; unpack8(w, f);
            *(GAS f32x4*)(orow + 512 * j) = (f32x4){f[0], f[1], f[2], f[3]} * rs * gv[2 * j];
            *(GAS f32x4*)(orow + 512 * j + 4) = (f32x4){f[4], f[5], f[6], f[7]} * rs * gv[2 * j + 1]; }
    }
}

#ifndef REP_KIND
#define REP_KIND -1
#define REP_N 1
#endif
#ifndef STAGGER_TICKS
#define STAGGER_TICKS 0
#endif
#define STAGGER() do { if (STAGGER_TICKS > 0 && ((blockIdx.x >> 3) & 1)) { const unsigned long long t0_ = __builtin_amdgcn_s_memrealtime(); while (__builtin_amdgcn_s_memrealtime() - t0_ < (unsigned long long)STAGGER_TICKS) __builtin_amdgcn_s_sleep(8); } } while (0)
#ifndef PH_MASK
#define PH_MASK 4095
#endif
__global__ void __launch_bounds__(NWAVES * 64, 2) mega_fwd(Args args) {
    extern __shared__ __attribute__((aligned(16))) unsigned char lds[];
    Frame F;
    F.lds = (LAS unsigned char*)lds;
    F.tid = threadIdx.x; F.lane = F.tid & 63; F.wave = __builtin_amdgcn_readfirstlane(F.tid >> 6);
    F.G = gridDim.x;
    F.ws = (GAS unsigned char*)args.ws; F.out = (GAS float*)args.out; F.ctl = (gu32*)(args.ws + WS_CTL);
    F.ap = (const __attribute__((address_space(4))) Args*)__builtin_amdgcn_kernarg_segment_ptr();
    for (int u = F.tid; u < (LDS_BYTES - LDSCTL_OFF) / 4; u += NWAVES * 64) ((LAS unsigned*)(F.lds + LDSCTL_OFF))[u] = 0u;
    __syncthreads();
    const int lo = args.ph_lo, hi = args.ph_hi;
    XcdBarrier bar; bar.bar = (unsigned*)(F.ctl + CW_BAR); bar.x = 0; bar.st = (volatile LAS unsigned*)(F.lds + MISC_OFF + 32);
    if (hi - lo > 1) bar = xcd_barrier_post((unsigned*)(F.ctl + CW_BAR), (volatile LAS unsigned*)(F.lds + MISC_OFF + 32));

    PG8_LAS float* escr = (PG8_LAS float*)(F.lds + EPI_SCR_OFF); PG8_LAS unsigned char* rtab = F.lds + RSTD_TAB_OFF;

    for (int ph = lo; ph < hi; ++ph) {
        const int kind_ = (ph == 0) ? 100 : (ph == N_PHASES - 1) ? 101 : ((ph - 1) & 7);
        #ifdef PROBE_NULL_C
        const int nrep = (kind_ == REP_KIND) ? REP_N : 1;
#else
        const int nrep = (kind_ == REP_KIND && !(kind_ == 4 && ph > 8)) ? REP_N : 1;
#endif
        for (int rep = 0; rep < nrep; ++rep) {
        { int t_ = threadIdx.x; asm volatile("" : "+v"(t_)); F.tid = t_; F.lane = t_ & 63; F.wave = __builtin_amdgcn_readfirstlane(t_ >> 6);
          const __attribute__((address_space(4))) Args* a_ = (const __attribute__((address_space(4))) Args*)__builtin_amdgcn_kernarg_segment_ptr(); asm volatile("" : "+s"(a_)); F.ap = a_;
          GAS unsigned char* w_ = (GAS unsigned char*)args.ws; asm volatile("" : "+s"(w_)); F.ws = w_; GAS float* o_ = (GAS float*)args.out; asm volatile("" : "+s"(o_)); F.out = o_; }
        GAS bf16* HB0 = (GAS bf16*)(F.ws + WS_HB); GAS bf16* HB1 = (GAS bf16*)F.out + (size_t)M * DM; GAS bf16* PROJ = (GAS bf16*)(F.ws + WS_PROJ); GAS bf16* MIX = (GAS bf16*)(F.ws + WS_U); GAS bf16* PB = (GAS bf16*)(F.ws + WS_PB);
        GAS float* SSQ[2] = {(GAS float*)(F.ws + WS_SSQ0), (GAS float*)(F.ws + WS_SSQ1)};
        if (ph == 0) { if (PH_MASK & 1) p0_prologue(F); }
        else if (ph == N_PHASES - 1) { if (PH_MASK & 2) final_norm(F, SSQ[0]); }
        else {
            const int L = (ph - 1) >> 3, s = (ph - 1) & 7;
            GAS float* sA = SSQ[L & 1]; GAS float* sB = SSQ[(L & 1) ^ 1];
            GAS bf16* HB = (L & 1) ? HB1 : HB0; GAS bf16* HBN = (L & 1) ? HB0 : HB1;
            if (s == 0) { if (PH_MASK & 4) {
                pg8::Gemm g{(const bf16*)HB, (const bf16*)w_ptr(F, L, WO_IN), M, NPROJ, 1024}; pg8::RstdOrder S; S.init(M, NPROJ, F.G, (int)blockIdx.x); S.ssq = sA; S.tab = rtab; S.tid = F.tid; S.cnt = 0;
                STAGGER();
                pg8::EpiProj E{PROJ, PS, rtab, ((const GAS float*)F.ap->in[5]) + L * 256, 0};
#ifdef PROBE_NULL_A
                if (rep + 1 < nrep) { pg8::EpiNull E0; pg8::gemm_phase<pg8::EpiNull, pg8::RstdOrder, true, true>(F.lds + RING_OFF, g, S, E0, F.tid); } else
#endif
                pg8::gemm_phase<pg8::EpiProj, pg8::RstdOrder, true, true>(F.lds + RING_OFF, g, S, E, F.tid); }
                { int t_ = F.tid; asm volatile("" : "+v"(t_)); F.tid = t_; }
                if (PH_MASK & 1024) { int kp_ = PLE; asm volatile("" : "+s"(kp_)); pg8::Gemm g{(const bf16*)(PB + (size_t)L * M * PLE), (const bf16*)w_ptr(F, L, WO_PP), M, 1024, kp_};
                  pg8::PPOrder S{F.G, (int)blockIdx.x}; pg8::EpiPP E{(GAS bf16*)F.out, 1024};
                  pg8::gemm_phase<pg8::EpiPP, pg8::PPOrder, true, true>(F.lds + RING_OFF, g, S, E, F.tid); }
            } else if (s == 1) { if (PH_MASK & 8) gla_p1(F, L); }
            else if (s == 2) { if (PH_MASK & 16) gla_p2(F, L); }
            else if (s == 3) { if (PH_MASK & 32) gla_p3(F, L); }
            else if (s == 4) { if (PH_MASK & 64) {
                pg8::Gemm g{(const bf16*)MIX, (const bf16*)w_ptr(F, L, WO_OUT), M, 1024, 1024}; pg8::StaticOrder S; S.init(M, 1024, F.G, (int)blockIdx.x);
                pg8::EpiRes<0> E{nullptr, HB, HB, sB, rtab, nullptr, escr, F.tid, 0};
#ifdef PROBE_NULL_C
                if (rep + 1 < nrep) { pg8::EpiNull E0; pg8::gemm_phase<pg8::EpiNull, pg8::StaticOrder, true, true>(F.lds + RING_OFF, g, S, E0, F.tid); } else
#endif
                pg8::gemm_phase<pg8::EpiRes<0>, pg8::StaticOrder, true, true>(F.lds + RING_OFF, g, S, E, F.tid); }
            } else if (s == 5) { if (PH_MASK & 128) {
                pg8::Gemm g{(const bf16*)HB, (const bf16*)w_ptr(F, L, WO_GU), M, 2 * FFN, 1024}; pg8::RstdOrder S; S.init(M, 2 * FFN, F.G, (int)blockIdx.x); S.ssq = sB; S.tab = rtab; S.tid = F.tid; S.cnt = 0;
                STAGGER();
                pg8::EpiSwiGLU E{PROJ, FFN, rtab, 0};
#ifdef PROBE_NORS_D
                if (rep + 1 < nrep) { pg8::EpiSwiGLU_<true> E0{PROJ, FFN, rtab, 0}; pg8::gemm_phase<pg8::EpiSwiGLU_<true>, pg8::RstdOrder, true, true>(F.lds + RING_OFF, g, S, E0, F.tid); } else
#endif
                pg8::gemm_phase<pg8::EpiSwiGLU, pg8::RstdOrder, true, true>(F.lds + RING_OFF, g, S, E, F.tid); }
            } else if (s == 6) { if (PH_MASK & 256) {
                pg8::Gemm g{(const bf16*)PROJ, (const bf16*)w_ptr(F, L, WO_DN), M, 1024, FFN}; pg8::StaticOrder S; S.init(M, 1024, F.G, (int)blockIdx.x);
                pg8::EpiRes<0> E{nullptr, HB, HB, sA, rtab, nullptr, escr, F.tid, 0};
#ifdef PROBE_NULL_E
                if (rep + 1 < nrep) { pg8::EpiNull E0; pg8::gemm_phase<pg8::EpiNull, pg8::StaticOrder, true, true>(F.lds + RING_OFF, g, S, E0, F.tid); } else
#endif
                pg8::gemm_phase<pg8::EpiRes<0>, pg8::StaticOrder, true, true>(F.lds + RING_OFF, g, S, E, F.tid); }
            } else { if (PH_MASK & 512) {
                if (PH_MASK & 2048) { pg8::Gemm g{(const bf16*)HB, (const bf16*)w_ptr(F, L, WO_PG), M, 1024, 1024}; pg8::RstdOrder S; S.init(M, 1024, F.G, (int)blockIdx.x); S.ssq = sA; S.tab = rtab; S.tid = F.tid; S.cnt = 0;
                  pg8::EpiRes<1> E{nullptr, HB, HBN, sB, rtab, (const GAS bf16*)F.out, escr, F.tid, 0};
#ifdef PROBE_NULL_F
                  if (rep + 1 < nrep) { pg8::EpiNull E0; pg8::gemm_phase<pg8::EpiNull, pg8::RstdOrder, true, true>(F.lds + RING_OFF, g, S, E0, F.tid); } else
#endif
                  pg8::gemm_phase<pg8::EpiRes<1>, pg8::RstdOrder, true, true>(F.lds + RING_OFF, g, S, E, F.tid); } }
            }
        }
        if (rep + 1 < nrep) xcd_barrier(bar);
        }
        if (ph + 1 < hi) xcd_barrier(bar);
#ifdef PROBE_XBAR
        if (ph + 1 < hi) { xcd_barrier(bar); xcd_barrier(bar); }
#endif
    }
}

#ifndef MK_ONE_LAUNCH
#define MK_ONE_LAUNCH 1
#endif
extern "C" void kernel_launch(void* const* d_in, const int* in_sizes, int n_in, void* d_out, int out_size, void* d_ws, size_t ws_size, hipStream_t stream) {
    static int grid = 0;
    if (grid == 0) {
        if (n_in != 16 || in_sizes[0] != M * DM || out_size != M * DM || ws_size < WS_END) { fprintf(stderr, "kernel_launch: unexpected shapes / workspace (%d inputs, in0 %d, out %d, ws %zu)\n", n_in, n_in > 0 ? in_sizes[0] : -1, out_size, ws_size); grid = -1; return; }
        int dev = 0, cus = 0, per_cu = 0;
        if (hipGetDevice(&dev) != hipSuccess || hipDeviceGetAttribute(&cus, hipDeviceAttributeMultiprocessorCount, dev) != hipSuccess) { grid = -1; return; }
        if (hipFuncSetAttribute((const void*)mega_fwd, hipFuncAttributeMaxDynamicSharedMemorySize, LDS_BYTES) != hipSuccess) { fprintf(stderr, "kernel_launch: hipFuncSetAttribute failed\n"); grid = -1; return; }
        if (hipOccupancyMaxActiveBlocksPerMultiprocessor(&per_cu, (const void*)mega_fwd, NWAVES * 64, LDS_BYTES) != hipSuccess || per_cu < 1) { fprintf(stderr, "kernel_launch: occupancy query says %d blocks per CU\n", per_cu); (void)hipGetLastError(); grid = -1; return; }
        grid = cus;
    }
    if (grid < 0) return;
    (void)hipMemsetAsync((char*)d_ws + WS_CTL, 0, CTL_ZERO_BYTES, stream);
    Args a{};
    for (int i = 0; i < 16; ++i) a.in[i] = (const float*)d_in[i];
    a.out = (float*)d_out; a.ws = (unsigned char*)d_ws;
#if MK_ONE_LAUNCH
    a.ph_lo = 0; a.ph_hi = N_PHASES;
    void* kargs[] = {&a};
    hipError_t e = hipLaunchCooperativeKernel((const void*)mega_fwd, dim3(grid), dim3(NWAVES * 64), kargs, LDS_BYTES, stream);
    if (e != hipSuccess) fprintf(stderr, "kernel_launch: cooperative launch failed: %s (grid %d)\n", hipGetErrorString(e), grid);
#else
    for (int ph = 0; ph < N_PHASES; ++ph) { a.ph_lo = ph; a.ph_hi = ph + 1; hipLaunchKernelGGL(mega_fwd, dim3(grid), dim3(NWAVES * 64), LDS_BYTES, stream, a); }
#endif
}
```

```cpp
#include <hip/hip_runtime.h>
#include <cstdio>
#include <cstdint>
namespace pg8 {
#define PG8_LAS __attribute__((address_space(3)))
typedef unsigned short bf16_t;
typedef short bf16x8 __attribute__((ext_vector_type(8)));
typedef float f32x4 __attribute__((ext_vector_type(4)));
typedef unsigned u32x4 __attribute__((ext_vector_type(4)));
constexpr int BM = 256, BK = 64, HALF = 128, HTB = HALF * BK * 2  , STAGE_BYTES = 8 * HTB, NXCD = 8, WGM = 8;

__host__ __device__ __forceinline__ int lds_byte(int r, int c) { const int st = (r >> 4) * 2 + (c >> 5), rr = r & 15, cc = c & 31, ob = rr * 64 + cc * 2; return st * 1024 + (ob ^ (((ob >> 9) & 1) << 5)); }
__host__ __device__ __forceinline__ void stage_rc(int b, int& R, int& C) { const int st = b / 1024, sb = b % 1024, swz = sb ^ (((sb >> 9) & 1) << 5); R = (st >> 1) * 16 + swz / 64; C = (st & 1) * 32 + (swz % 64) / 2; }
__host__ __device__ __forceinline__ int perm32(int rho) { const int n = rho >> 4, i = rho & 15; return 8 * (i >> 2) + 4 * n + (i & 3); }

struct Unit { int pm, pn; };
struct Gemm { const bf16_t* A; const bf16_t* Bt; int M, N, K; };

struct StaticOrder {
    int nM, nN, nwg, G, c;
    __host__ __device__ void init(int M, int N, int G_, int c_) { nM = M / BM; nN = N / BM; nwg = nM * nN; G = G_; c = c_; }
    __host__ __device__ bool next(int i, Unit& u) const {
        const long L = (long)i * G + c; if (L >= nwg) return false;
        int wgid = (int)L; { const int q = nwg / NXCD, r = nwg % NXCD, xcd = wgid % NXCD, off = wgid / NXCD; wgid = (xcd < r ? xcd * (q + 1) : r * (q + 1) + (xcd - r) * q) + off; }
        const int nig = WGM * nN, gid = wgid / nig, fm = gid * WGM, gsz = (nM - fm) < WGM ? (nM - fm) : WGM;
        u.pm = fm + ((wgid % nig) % gsz); u.pn = (wgid % nig) / gsz; return true;
    }
    __device__ __forceinline__ void a_ready(const Unit&) const {}
    __device__ __forceinline__ void done(const Unit&) const {}
};


typedef float f32x2_cv __attribute__((ext_vector_type(2))); typedef __bf16 bf16x2_cv __attribute__((ext_vector_type(2)));
__device__ __forceinline__ unsigned cvt_pk_bf16(float lo, float hi) { const f32x2_cv v = {lo, hi}; const bf16x2_cv b = __builtin_convertvector(v, bf16x2_cv); return __builtin_bit_cast(unsigned, b); }
typedef unsigned u32x2 __attribute__((ext_vector_type(2)));
#define PG8_GAS __attribute__((address_space(1)))
constexpr float RMS_EPS = 1e-6f;
__device__ __forceinline__ float fast_rcp(float x) { return __builtin_amdgcn_rcpf(x); }
__device__ __forceinline__ float fast_exp(float x) { return __builtin_amdgcn_exp2f(x * 1.4426950408889634f); }
__device__ __forceinline__ float fast_log(float x) { return __builtin_amdgcn_logf(x) * 0.6931471805599453f; }
__device__ __forceinline__ float sigmoidf_(float x) { return fast_rcp(1.0f + fast_exp(-x)); }
__device__ __forceinline__ float siluf_(float x) { return x * sigmoidf_(x); }
__device__ __forceinline__ float logsig16(float x) { return (fminf(x, 0.f) - fast_log(1.0f + fast_exp(-fabsf(x)))) * 0.0625f; }
__device__ __forceinline__ float rstd_from(const PG8_GAS float* ssq, int row) { const f32x4 s = *(const PG8_GAS f32x4*)(ssq + (size_t)row * 4); return __builtin_amdgcn_rsqf(((s[0] + s[1]) + (s[2] + s[3])) * (1.0f / 1024.0f) + RMS_EPS); }

__device__ __forceinline__ float rstd_tab(const PG8_LAS unsigned char* tab, int par, int rl) { const f32x4 s = *(const PG8_LAS f32x4*)(tab + par * 4096 + rl * 16); return __builtin_amdgcn_rsqf(((s[0] + s[1]) + (s[2] + s[3])) * (1.0f / 1024.0f) + RMS_EPS); }
struct RstdOrder : StaticOrder {
    const PG8_GAS float* ssq; PG8_LAS unsigned char* tab; int tid; mutable int cnt;
    __device__ __forceinline__ void a_ready(const Unit& u) const {
        const int w = __builtin_amdgcn_readfirstlane(tid >> 6);
        if (w < 4) __builtin_amdgcn_global_load_lds((const unsigned*)(ssq + (size_t)(u.pm * BM + tid) * 4), (PG8_LAS unsigned*)(tab + (cnt & 1) * 4096 + w * 1024), 16, 0, 0);
        ++cnt;
    }
};
struct EpiProj {
    static constexpr bool PERM = true, AFTER_DRAIN = false;
    PG8_GAS bf16_t* O; int ldc; const PG8_LAS unsigned char* tab; const PG8_GAS float* bgate; mutable int ui;
    __device__ __forceinline__ void operator()(const f32x4 (&acc)[2][2][4][2], const Unit& u, int wr, int wc, int fr, int fq) const {
        const int row0 = u.pm * BM + wr * 64 + fr, rl0 = wr * 64 + fr, par = ui & 1; ++ui;
        const int kind = (u.pn == 12) ? 2 : (u.pn >= 8 ? 1 : 0);
        if (kind == 1) {
            const int col0 = 2048 + (u.pn - 8) * HALF + wc * 32 + 8 * fq;
#pragma unroll
            for (int ai = 0; ai < 2; ++ai)
#pragma unroll
                for (int m = 0; m < 4; ++m) { const int row = row0 + ai * HALF + m * 16; const float rs = rstd_tab(tab, par, rl0 + ai * HALF + m * 16), rs2 = rs * rs;
                    const f32x4 h0 = acc[ai][0][m][0] * acc[ai][1][m][0] * rs2, h1 = acc[ai][0][m][1] * acc[ai][1][m][1] * rs2;
                    u32x4 w; w.x = cvt_pk_bf16(h0[0], h0[1]); w.y = cvt_pk_bf16(h0[2], h0[3]); w.z = cvt_pk_bf16(h1[0], h1[1]); w.w = cvt_pk_bf16(h1[2], h1[3]);
                    *(PG8_GAS u32x4*)(O + (size_t)row * ldc + col0) = w; }
            return;
        }
        const bool isg = (kind == 2);
        const int col0 = (isg ? 2560 : u.pn * BM) + wc * 32 + 8 * fq;
        f32x4 bv[2][2];
#pragma unroll
        for (int bj = 0; bj < 2; ++bj)
#pragma unroll
            for (int n = 0; n < 2; ++n) bv[bj][n] = isg ? *(const PG8_GAS f32x4*)(bgate + wc * 32 + 8 * fq + bj * HALF + 4 * n) : (f32x4){0.f, 0.f, 0.f, 0.f};
#pragma unroll
        for (int ai = 0; ai < 2; ++ai)
#pragma unroll
            for (int m = 0; m < 4; ++m) { const int row = row0 + ai * HALF + m * 16; const float rs = rstd_tab(tab, par, rl0 + ai * HALF + m * 16); PG8_GAS bf16_t* rowp = O + (size_t)row * ldc + col0;
#pragma unroll
                for (int bj = 0; bj < 2; ++bj) { f32x4 v0 = acc[ai][bj][m][0] * rs, v1 = acc[ai][bj][m][1] * rs;
                    if (isg) { v0 = v0 + bv[bj][0]; v1 = v1 + bv[bj][1];
#pragma unroll
                        for (int i = 0; i < 4; ++i) { v0[i] = logsig16(v0[i]); v1[i] = logsig16(v1[i]); } }
                    u32x4 w; w.x = cvt_pk_bf16(v0[0], v0[1]); w.y = cvt_pk_bf16(v0[2], v0[3]); w.z = cvt_pk_bf16(v1[0], v1[1]); w.w = cvt_pk_bf16(v1[2], v1[3]);
                    *(PG8_GAS u32x4*)(rowp + bj * HALF) = w; } }
    }
};
template <bool NORS = false> struct EpiSwiGLU_ {
    static constexpr bool PERM = true, AFTER_DRAIN = false;
    PG8_GAS bf16_t* O; int ldc; const PG8_LAS unsigned char* tab; mutable int ui;
    __device__ __forceinline__ void operator()(const f32x4 (&acc)[2][2][4][2], const Unit& u, int wr, int wc, int fr, int fq) const {
        const int row0 = u.pm * BM + wr * 64 + fr, col0 = u.pn * HALF + wc * 32 + 8 * fq, rl0 = wr * 64 + fr, par = ui & 1; ++ui;
#pragma unroll
        for (int ai = 0; ai < 2; ++ai)
#pragma unroll
            for (int m = 0; m < 4; ++m) { const int row = row0 + ai * HALF + m * 16; const float rs = NORS ? 1.0f : rstd_tab(tab, par, rl0 + ai * HALF + m * 16); const float k1 = rs * -1.4426950408889634f, k2 = rs * rs;
                f32x4 h0, h1;
                { const f32x4 a = acc[ai][0][m][0], b = acc[ai][1][m][0]; const f32x4 num = a * b * k2, ex = a * k1;
#pragma unroll
                  for (int i = 0; i < 4; ++i) h0[i] = num[i] * fast_rcp(1.0f + __builtin_amdgcn_exp2f(ex[i])); }
                { const f32x4 a = acc[ai][0][m][1], b = acc[ai][1][m][1]; const f32x4 num = a * b * k2, ex = a * k1;
#pragma unroll
                  for (int i = 0; i < 4; ++i) h1[i] = num[i] * fast_rcp(1.0f + __builtin_amdgcn_exp2f(ex[i])); }
                u32x4 w; w.x = cvt_pk_bf16(h0[0], h0[1]); w.y = cvt_pk_bf16(h0[2], h0[3]); w.z = cvt_pk_bf16(h1[0], h1[1]); w.w = cvt_pk_bf16(h1[2], h1[3]);
                *(PG8_GAS u32x4*)(O + (size_t)row * ldc + col0) = w; }
    }
};
typedef EpiSwiGLU_<false> EpiSwiGLU;
struct EpiPP {
    static constexpr bool PERM = true, AFTER_DRAIN = false;
    PG8_GAS bf16_t* O; int ldc;
    __device__ __forceinline__ void operator()(const f32x4 (&acc)[2][2][4][2], const Unit& u, int wr, int wc, int fr, int fq) const {
        const int row0 = u.pm * BM + wr * 64 + fr, col0 = u.pn * BM + wc * 32 + 8 * fq;
#pragma unroll
        for (int ai = 0; ai < 2; ++ai)
#pragma unroll
            for (int m = 0; m < 4; ++m) { PG8_GAS bf16_t* rowp = O + (size_t)(row0 + ai * HALF + m * 16) * ldc + col0;
#pragma unroll
                for (int bj = 0; bj < 2; ++bj) { const f32x4 v0 = acc[ai][bj][m][0], v1 = acc[ai][bj][m][1];
                    u32x4 w; w.x = cvt_pk_bf16(v0[0], v0[1]); w.y = cvt_pk_bf16(v0[2], v0[3]); w.z = cvt_pk_bf16(v1[0], v1[1]); w.w = cvt_pk_bf16(v1[2], v1[3]);
                    *(PG8_GAS u32x4*)(rowp + bj * HALF) = w; } }
    }
};
template <int MODE> struct EpiRes {
    static constexpr bool PERM = false, AFTER_DRAIN = false;
    const PG8_GAS float* basef; const PG8_GAS bf16_t* hbin; PG8_GAS bf16_t* hb; PG8_GAS float* ssq_out; const PG8_LAS unsigned char* tab; const PG8_GAS bf16_t* pp; PG8_LAS float* scr; int tid; mutable int ui;
    __device__ __forceinline__ void operator()(const f32x4 (&acc_)[2][2][4][2], const Unit& u, int wr, int wc, int fr, int fq) const {
        f32x4 (&acc)[2][2][4][2] = const_cast<f32x4 (&)[2][2][4][2]>(acc_);
        const int col0 = u.pn * BM + wc * 32 + 4 * fq, par = ui & 1; ++ui;
#pragma unroll
        for (int ai = 0; ai < 2; ++ai) {
            u32x2 bw[4][2][2], pw[4][2][2];
#pragma unroll
            for (int m = 0; m < 4; ++m) { const size_t off = (size_t)(u.pm * BM + ai * HALF + wr * 64 + m * 16 + fr) * 1024 + col0;
#pragma unroll
                for (int bj = 0; bj < 2; ++bj)
#pragma unroll
                    for (int n = 0; n < 2; ++n) { const size_t c = off + bj * HALF + n * 16;
                        if (MODE == 1) pw[m][bj][n] = *(const PG8_GAS u32x2*)(pp + c);
                        bw[m][bj][n] = *(const PG8_GAS u32x2*)(hbin + c); } }
#pragma unroll
            for (int m = 0; m < 4; ++m) { const int rl = ai * HALF + wr * 64 + m * 16 + fr; const size_t off = (size_t)(u.pm * BM + rl) * 1024 + col0;
                float rs = 1.0f; if (MODE == 1) rs = rstd_tab(tab, par, rl) * -1.4426950408889634f;
                float part = 0.f;
#pragma unroll
                for (int bj = 0; bj < 2; ++bj)
#pragma unroll
                    for (int n = 0; n < 2; ++n) { const size_t c = off + bj * HALF + n * 16; f32x4 v = acc[ai][bj][m][n];
                        if (MODE == 1) { const u32x2 q = pw[m][bj][n];
                            v[0] = __uint_as_float(q.x << 16) * fast_rcp(1.0f + __builtin_amdgcn_exp2f(v[0] * rs)); v[1] = __uint_as_float(q.x & 0xffff0000u) * fast_rcp(1.0f + __builtin_amdgcn_exp2f(v[1] * rs));
                            v[2] = __uint_as_float(q.y << 16) * fast_rcp(1.0f + __builtin_amdgcn_exp2f(v[2] * rs)); v[3] = __uint_as_float(q.y & 0xffff0000u) * fast_rcp(1.0f + __builtin_amdgcn_exp2f(v[3] * rs)); }
                        const u32x2 b2 = bw[m][bj][n]; f32x4 b; b[0] = __uint_as_float(b2.x << 16); b[1] = __uint_as_float(b2.x & 0xffff0000u); b[2] = __uint_as_float(b2.y << 16); b[3] = __uint_as_float(b2.y & 0xffff0000u);
                        const f32x4 o = b + v;
                        { u32x2 w; w.x = cvt_pk_bf16(o[0], o[1]); w.y = cvt_pk_bf16(o[2], o[3]); *(PG8_GAS u32x2*)(hb + c) = w; }
                        part += (o[0] * o[0] + o[1] * o[1]) + (o[2] * o[2] + o[3] * o[3]); }
                part += __shfl_xor(part, 16); part += __shfl_xor(part, 32);
                if (fq == 0) scr[rl * 4 + wc] = part; }
            asm volatile("" ::: "memory");
        }
        asm volatile("s_waitcnt lgkmcnt(0)" ::: "memory"); __builtin_amdgcn_s_barrier(); asm volatile("" ::: "memory");
        { const int t = tid & 255;
          if (t < 128) { const int rl = (t >> 6) * HALF + wr * 64 + (t & 63); const f32x4 p4 = *(const PG8_LAS f32x4*)(scr + rl * 4);
              ssq_out[(size_t)(u.pm * BM + rl) * 4 + u.pn] = (p4[0] + p4[1]) + (p4[2] + p4[3]); } }
        asm volatile("s_waitcnt lgkmcnt(0)" ::: "memory");
    }
};
struct PPOrder {
    int G, c;
    __device__ __forceinline__ bool next(int i, Unit& u) const {
        int idx;
        if (G == 256) { if (c < 128) { if (i >= 1) return false; idx = 384 + c; } else { if (i >= 3) return false; idx = 3 * (c - 128) + i; } }
        else { idx = i * G + c; if (idx >= 512) return false; }
        u.pm = idx >> 2; u.pn = idx & 3; return true;
    }
    __device__ __forceinline__ void a_ready(const Unit&) const {}
    __device__ __forceinline__ void done(const Unit&) const {}
};
struct EpiNull {
    static constexpr bool PERM = true, AFTER_DRAIN = false;
    __device__ __forceinline__ void operator()(const f32x4 (&acc)[2][2][4][2], const Unit& u, int wr, int wc, int fr, int fq) const {
#pragma unroll
        for (int ai = 0; ai < 2; ++ai)
#pragma unroll
            for (int bj = 0; bj < 2; ++bj)
#pragma unroll
                for (int m = 0; m < 4; ++m)
#pragma unroll
                    for (int n = 0; n < 2; ++n) asm volatile("" :: "v"(acc[ai][bj][m][n]));
    }
};
template <class Epi, class Sched, bool ALIGN_EPI = false, bool SP2 = false>
__device__ __forceinline__ void gemm_phase(PG8_LAS unsigned char* lds, const Gemm g, const Sched& S, const Epi& E, const int tid) {
    const int wid = __builtin_amdgcn_readfirstlane(tid >> 6), lane = tid & 63, wr = wid >> 2, wc = wid & 3, fr = lane & 15, fq = lane >> 4;
    const int K = g.K, nt = K / BK;
    unsigned voffA[2], voffB[2];
#pragma unroll
    for (int i = 0; i < 2; ++i) { int R, C; stage_rc(tid * 16 + i * 8192, R, C); const int Rb = Epi::PERM ? ((R & ~31) + perm32(R & 31)) : R;
        voffA[i] = (unsigned)(R * K + C) * 2u; voffB[i] = (unsigned)(Rb * K + C) * 2u; }
    const size_t kstep = (size_t)(BK * 2);
    const size_t hstep = (size_t)HALF * K * 2;
    const size_t tstep = 2 * hstep;
    const unsigned ldsw = (unsigned)wid * 1024u;
    const int aoff = lds_byte(wr * 64 + fr, fq * 8), boff = lds_byte(wc * 32 + fr, fq * 8);
#define PG8_SA(b, h) (((b) * 2 + (h)) * HTB)
#define PG8_SB(b, h) ((4 + (b) * 2 + (h)) * HTB)
#define PG8_STAGE(bufoff, gbase, voff) do { _Pragma("unroll") for (int _i = 0; _i < 2; ++_i) \
        __builtin_amdgcn_global_load_lds((const unsigned*)((const char*)(gbase) + (voff)[_i]), (PG8_LAS unsigned*)(lds + (bufoff) + ldsw + _i * 8192), 16, 0, 0); } while (0)
#define PG8_LDA(dst, b, h) do { _Pragma("unroll") for (int m = 0; m < 4; ++m) _Pragma("unroll") for (int k = 0; k < 2; ++k) dst[m][k] = *(const PG8_LAS bf16x8*)(lds + PG8_SA(b, h) + aoff + m * 2048 + k * 1024); } while (0)
#define PG8_LDB(dst, b, h) do { _Pragma("unroll") for (int n = 0; n < 2; ++n) _Pragma("unroll") for (int k = 0; k < 2; ++k) dst[n][k] = *(const PG8_LAS bf16x8*)(lds + PG8_SB(b, h) + boff + n * 2048 + k * 1024); } while (0)
#define PG8_MMA(ai, bj, At, Bt) do { __builtin_amdgcn_s_setprio(1); _Pragma("unroll") for (int m = 0; m < 4; ++m) _Pragma("unroll") for (int n = 0; n < 2; ++n) _Pragma("unroll") for (int k = 0; k < 2; ++k) \
        acc[ai][bj][m][n] = __builtin_amdgcn_mfma_f32_16x16x32_bf16(Bt[n][k], At[m][k], acc[ai][bj][m][n], 0, 0, 0); __builtin_amdgcn_s_setprio(0); } while (0)
#define PG8_WAIT_V(n) asm volatile("s_waitcnt vmcnt(" #n ")" ::: "memory")
#define PG8_WAIT_L(n) asm volatile("s_waitcnt lgkmcnt(" #n ")" ::: "memory")
#define PG8_BAR __builtin_amdgcn_s_barrier()
#define PG8_SCHED __builtin_amdgcn_sched_barrier(0)
    Unit cur, nxt; int ui = 0;
    if (!S.next(0, cur)) return;
    f32x4 acc[2][2][4][2];
#pragma unroll
    for (int a = 0; a < 2; ++a)
#pragma unroll
        for (int b = 0; b < 2; ++b)
#pragma unroll
            for (int m = 0; m < 4; ++m)
#pragma unroll
                for (int n = 0; n < 2; ++n) acc[a][b][m][n] = (f32x4){0.f, 0.f, 0.f, 0.f};
    bf16x8 At[4][2], B0[2][2], B1[2][2];
    const char* cA = (const char*)g.A + (size_t)cur.pm * tstep; const char* cB = (const char*)g.Bt + (size_t)cur.pn * tstep;
    S.a_ready(cur);
    if constexpr (SP2) {
        PG8_STAGE(PG8_SB(0, 0), cB, voffB); PG8_STAGE(PG8_SB(0, 1), cB + hstep, voffB); PG8_STAGE(PG8_SA(0, 0), cA, voffA); PG8_STAGE(PG8_SA(0, 1), cA + hstep, voffA);
        if (wr == 1) PG8_BAR;
        PG8_WAIT_V(2); PG8_BAR;
        PG8_STAGE(PG8_SB(1, 0), cB + kstep, voffB); PG8_STAGE(PG8_SA(1, 0), cA + kstep, voffA); PG8_STAGE(PG8_SB(1, 1), cB + hstep + kstep, voffB);
        PG8_WAIT_V(6); PG8_BAR;
    } else {
        PG8_STAGE(PG8_SB(0, 0), cB, voffB); PG8_STAGE(PG8_SA(0, 0), cA, voffA); PG8_STAGE(PG8_SB(0, 1), cB + hstep, voffB); PG8_STAGE(PG8_SA(0, 1), cA + hstep, voffA);
        if (wr == 1) PG8_BAR;
        PG8_WAIT_V(4); PG8_BAR;
        PG8_STAGE(PG8_SB(1, 0), cB + kstep, voffB); PG8_STAGE(PG8_SA(1, 0), cA + kstep, voffA); PG8_STAGE(PG8_SB(1, 1), cB + hstep + kstep, voffB);
        PG8_WAIT_V(6); PG8_BAR;
    }
    for (;;) {
        const bool has_next = S.next(ui + 1, nxt);
        const char* nA = has_next ? (const char*)g.A + (size_t)nxt.pm * tstep : cA; const char* nB = has_next ? (const char*)g.Bt + (size_t)nxt.pn * tstep : cB;
        for (int t = 0; t < nt; t += 2) {
            const bool last = (t == nt - 2);
            const char* a1 = cA + (size_t)(t + 1) * kstep;
            const char* a2 = last ? nA : cA + (size_t)(t + 2) * kstep; const char* b2 = last ? nB : cB + (size_t)(t + 2) * kstep;
            const char* a3 = a2 + kstep; const char* b3 = b2 + kstep;
            if (last && has_next) S.a_ready(nxt);
            if constexpr (SP2) {
            PG8_LDB(B0, 0, 0); PG8_LDB(B1, 0, 1); PG8_SCHED; PG8_LDA(At, 0, 0); PG8_STAGE(PG8_SA(1, 1), a1 + hstep, voffA);
            PG8_WAIT_V(8); PG8_WAIT_L(0); PG8_BAR; PG8_MMA(0, 0, At, B0); PG8_MMA(0, 1, At, B1); PG8_BAR; PG8_SCHED;
            PG8_LDA(At, 0, 1); PG8_STAGE(PG8_SB(0, 0), b2, voffB); PG8_STAGE(PG8_SB(0, 1), b2 + hstep, voffB); PG8_STAGE(PG8_SA(0, 0), a2, voffA);
            PG8_WAIT_V(8); PG8_WAIT_L(0); PG8_BAR; PG8_MMA(1, 0, At, B0); PG8_MMA(1, 1, At, B1); PG8_BAR; PG8_SCHED;
            PG8_LDB(B0, 1, 0); PG8_LDB(B1, 1, 1); PG8_SCHED; PG8_LDA(At, 1, 0); PG8_STAGE(PG8_SA(0, 1), a2 + hstep, voffA);
            PG8_WAIT_V(8); PG8_WAIT_L(0); PG8_BAR; PG8_MMA(0, 0, At, B0); PG8_MMA(0, 1, At, B1); PG8_BAR; PG8_SCHED;
            PG8_LDA(At, 1, 1); PG8_STAGE(PG8_SB(1, 0), b3, voffB); PG8_STAGE(PG8_SB(1, 1), b3 + hstep, voffB); PG8_STAGE(PG8_SA(1, 0), a3, voffA);
            PG8_WAIT_V(8); PG8_WAIT_L(0); PG8_BAR; PG8_MMA(1, 0, At, B0); PG8_MMA(1, 1, At, B1); PG8_BAR; PG8_SCHED;
            } else {
            PG8_LDB(B0, 0, 0); PG8_SCHED; PG8_LDA(At, 0, 0); PG8_STAGE(PG8_SA(1, 1), a1 + hstep, voffA);
            PG8_WAIT_L(8); PG8_BAR; PG8_WAIT_L(0); PG8_MMA(0, 0, At, B0); PG8_BAR; PG8_SCHED;
            PG8_LDB(B1, 0, 1); PG8_STAGE(PG8_SB(0, 0), b2, voffB);
            PG8_BAR; PG8_WAIT_L(0); PG8_MMA(0, 1, At, B1); PG8_BAR;
            PG8_LDA(At, 0, 1); PG8_STAGE(PG8_SA(0, 0), a2, voffA);
            PG8_BAR; PG8_WAIT_L(0); PG8_MMA(1, 0, At, B0); PG8_BAR; PG8_SCHED;
            PG8_STAGE(PG8_SB(0, 1), b2 + hstep, voffB);
            PG8_WAIT_V(6); PG8_BAR; PG8_MMA(1, 1, At, B1); PG8_BAR;
            PG8_LDB(B0, 1, 0); PG8_SCHED; PG8_LDA(At, 1, 0); PG8_STAGE(PG8_SA(0, 1), a2 + hstep, voffA);
            PG8_WAIT_L(8); PG8_BAR; PG8_WAIT_L(0); PG8_MMA(0, 0, At, B0); PG8_BAR; PG8_SCHED;
            PG8_LDB(B1, 1, 1); PG8_STAGE(PG8_SB(1, 0), b3, voffB);
            PG8_BAR; PG8_WAIT_L(0); PG8_MMA(0, 1, At, B1); PG8_BAR;
            PG8_LDA(At, 1, 1); PG8_STAGE(PG8_SA(1, 0), a3, voffA);
            PG8_BAR; PG8_WAIT_L(0); PG8_MMA(1, 0, At, B0); PG8_BAR; PG8_SCHED;
            PG8_STAGE(PG8_SB(1, 1), b3 + hstep, voffB);
            PG8_WAIT_V(6); PG8_BAR; PG8_MMA(1, 1, At, B1); PG8_BAR;
            }
        }
        if constexpr (ALIGN_EPI) { if (wr == 0) PG8_BAR; }
        if constexpr (!Epi::AFTER_DRAIN) { E(acc, cur, wr, wc, fr, fq); S.done(cur); }
        if (!has_next) break;
#pragma unroll
        for (int a = 0; a < 2; ++a)
#pragma unroll
            for (int b = 0; b < 2; ++b)
#pragma unroll
                for (int m = 0; m < 4; ++m)
#pragma unroll
                    for (int n = 0; n < 2; ++n) acc[a][b][m][n] = (f32x4){0.f, 0.f, 0.f, 0.f};
        cur = nxt; cA = nA; cB = nB; ++ui;
        if constexpr (ALIGN_EPI) { if (wr == 1) PG8_BAR; }
    }
    PG8_WAIT_V(0);
    if constexpr (!ALIGN_EPI) { if (wr == 0) PG8_BAR; }
    PG8_BAR;
    if constexpr (Epi::AFTER_DRAIN) { E.fused(acc, cur, wr, wc, fr, fq, lds, wid, lane); S.done(cur); }
#undef PG8_SA
#undef PG8_SB
#undef PG8_STAGE
#undef PG8_LDA
#undef PG8_LDB
#undef PG8_MMA
#undef PG8_WAIT_V
#undef PG8_WAIT_L
#undef PG8_BAR
#undef PG8_SCHED
}
}

constexpr int NWAVES = 8;
constexpr int BATCH = 4, SEQ = 8192, DM = 1024, DEPTH = 2, M = BATCH * SEQ;
constexpr int NH = 4, DK = 64, DV = 128, CHUNK = 64, NCH = SEQ / CHUNK;
constexpr int NITEM = BATCH * NH * NCH;
constexpr int IN_DIM = 3088, FFN = 2816, PLE = 256, CONVD = 512;
constexpr int NPROJ = 3328;
constexpr int PS = 2816;
constexpr int PC_Q = 0, PC_K = 256, PC_V = 512, PC_G = 1024, PC_CB = 1536, PC_U = 2048, PC_LA = 2560;
constexpr int N_PHASES = 18;

constexpr size_t MiB = 1u << 20;
constexpr size_t WS_CTL = 0, CTL_ZERO_BYTES = 1 * MiB;
constexpr size_t WS_SSQ0 = 1 * MiB, WS_SSQ1 = 1 * MiB + 512 * 1024;
constexpr size_t WS_DECAY = 2 * MiB;
constexpr size_t WS_W = 4 * MiB, W_LAYER = 28 * MiB;
constexpr size_t WO_IN = 0, WO_OUT = 6815744, WO_GU = WO_OUT + 2 * MiB, WO_DN = WO_GU + 11 * MiB, WO_PG = WO_DN + 5767168, WO_PP = WO_PG + 2 * MiB;
static_assert(WO_PP + 512 * 1024 <= W_LAYER, "weights per layer");
constexpr size_t WS_HB = 64 * MiB;
constexpr size_t WS_PROJ = 128 * MiB;
constexpr size_t WS_U = 336 * MiB;
constexpr size_t WS_S = 400 * MiB;
constexpr size_t WS_PB = 432 * MiB;
constexpr size_t WS_UB = 464 * MiB;
constexpr size_t WS_END = 496 * MiB;
constexpr int CW_BAR = 4096;

constexpr int RING_OFF = 0, RING_BYTES = 131072;
constexpr int EPI_SCR_OFF = RING_BYTES;
constexpr int RSTD_TAB_OFF = RING_BYTES + 4096;
constexpr int LDSCTL_OFF = RING_BYTES + 4096 + 8192, MISC_OFF = LDSCTL_OFF + 320;
constexpr int LDS_BYTES = 147456;
constexpr int G_TOT = 0, G_QT = 2048, G_KT = 12288, G_VT = 24576, G_ST = 45056, G_OST = 65536, G_UT = 45056;
constexpr int QK_STRIDE = 144, KD_STRIDE = 192, V_STRIDE = 320, OST_STRIDE = 528, U_STRIDE = 272;

#define GAS __attribute__((address_space(1)))
#define LAS __attribute__((address_space(3)))
typedef unsigned short bf16;
typedef unsigned v4u __attribute__((ext_vector_type(4)));
typedef unsigned v2u __attribute__((ext_vector_type(2)));
typedef float f32x4 __attribute__((ext_vector_type(4)));
typedef float f32x16 __attribute__((ext_vector_type(16)));
typedef short bf16x8 __attribute__((ext_vector_type(8)));
typedef short s16x4 __attribute__((ext_vector_type(4)));
typedef GAS unsigned gu32;
#define RLX_AGENT __ATOMIC_RELAXED, __HIP_MEMORY_SCOPE_AGENT
#define LDS_WAIT() asm volatile("s_waitcnt lgkmcnt(0)" ::: "memory")
#define VM_WAIT() asm volatile("s_waitcnt vmcnt(0)" ::: "memory")
using pg8::cvt_pk_bf16; using pg8::fast_exp; using pg8::fast_rcp; using pg8::siluf_;
__device__ __forceinline__ float bf_lo(unsigned w) { return __uint_as_float(w << 16); }
__device__ __forceinline__ float bf_hi(unsigned w) { return __uint_as_float(w & 0xffff0000u); }
__device__ __forceinline__ void unpack8(const v4u& w, float (&f)[8]) { f[0] = bf_lo(w.x); f[1] = bf_hi(w.x); f[2] = bf_lo(w.y); f[3] = bf_hi(w.y); f[4] = bf_lo(w.z); f[5] = bf_hi(w.z); f[6] = bf_lo(w.w); f[7] = bf_hi(w.w); }
__device__ __forceinline__ v4u pack8(const float (&f)[8]) { v4u w; w.x = cvt_pk_bf16(f[0], f[1]); w.y = cvt_pk_bf16(f[2], f[3]); w.z = cvt_pk_bf16(f[4], f[5]); w.w = cvt_pk_bf16(f[6], f[7]); return w; }
#define XB_TMO      128
#define XB_XCNT(j)  (256  + 64 * (j))
#define XB_XSUB(j)  (1280 + 64 * (j))
#define XB_XGEN(j)  (2304 + 64 * (j))
#define XB_TOP      3328
#define XB_TOPGEN   3392
#define XCD_BAR_WORDS 3456
#define XB_SPIN_CAP (1u << 18)

__device__ __forceinline__ unsigned xb_ld(unsigned* p)              { return __hip_atomic_load(p, __ATOMIC_RELAXED, __HIP_MEMORY_SCOPE_AGENT); }
__device__ __forceinline__ unsigned xb_add(unsigned* p, unsigned v) { return __hip_atomic_fetch_add(p, v, __ATOMIC_RELAXED, __HIP_MEMORY_SCOPE_AGENT); }
__device__ __forceinline__ unsigned xb_xcc_id() { return (unsigned)__builtin_amdgcn_s_getreg((3 << 11) | 20) & 0xFu; }
#define XB_SPIN(cond, bar) do { unsigned _sp = 0; while (cond) { __builtin_amdgcn_s_sleep(1); \
    if ((++_sp & 255u) == 0u) { if (xb_ld(&(bar)[XB_TMO])) break; if (_sp > XB_SPIN_CAP) { atomicAdd(&(bar)[XB_TMO], 1u); break; } } } } while (0)

struct XcdBarrier {
    unsigned* bar; unsigned x;
    volatile LAS unsigned* st;
};

__device__ __forceinline__ XcdBarrier xcd_barrier_post(unsigned* bar, volatile LAS unsigned* st) {
    XcdBarrier b; b.bar = bar; b.x = xb_xcc_id(); b.st = st;
    if (threadIdx.x == 0) (void)xb_add(&bar[XB_XCNT(b.x)], 1u);
    return b;
}
__device__ __forceinline__ void xcd_barrier_complete(unsigned* bar, unsigned x, unsigned& nloc, unsigned& nx) {
    const unsigned G = gridDim.x * gridDim.y * gridDim.z;
    unsigned sum, cnt, mine, sp = 0u;
    for (;;) {
        sum = 0u; cnt = 0u; mine = 0u;
#pragma unroll
        for (unsigned j = 0; j < 16; ++j) { const unsigned c = xb_ld(&bar[XB_XCNT(j)]); sum += c; cnt += (c > 0u) ? 1u : 0u; mine = (j == x) ? c : mine; }
        if (sum == G) break;
        __builtin_amdgcn_s_sleep(1);
        if ((++sp & 255u) == 0u) { if (xb_ld(&bar[XB_TMO])) break; if (sp > XB_SPIN_CAP) { atomicAdd(&bar[XB_TMO], 1u); break; } }
    }
    nloc = mine > 0u ? mine : 1u; nx = cnt > 0u ? cnt : 1u;
}

__device__ __forceinline__ void xcd_barrier(const XcdBarrier& b) {
    asm volatile("s_waitcnt vmcnt(0)" ::: "memory");
    __syncthreads();
    if (threadIdx.x == 0) {
        unsigned* bar = b.bar;
        __builtin_amdgcn_s_waitcnt(0);
        unsigned nloc = b.st[0], nx = b.st[1];
        if (nloc == 0u) { xcd_barrier_complete(bar, b.x, nloc, nx); b.st[0] = nloc; b.st[1] = nx; }
        const unsigned old = xb_add(&bar[XB_XSUB(b.x)], 1u);
        const unsigned gen = old / nloc;
        if (old + 1u == (gen + 1u) * nloc) {
            __builtin_amdgcn_fence(__ATOMIC_RELEASE, "agent");
            asm volatile("s_waitcnt vmcnt(0)" ::: "memory");
            const unsigned og = xb_add(&bar[XB_TOP], 1u);
            const unsigned tg = og / nx;
            if (og + 1u == (tg + 1u) * nx) xb_add(&bar[XB_TOPGEN], 1u);
            else XB_SPIN(xb_ld(&bar[XB_TOPGEN]) == tg, bar);
            __builtin_amdgcn_fence(__ATOMIC_ACQUIRE, "agent");
            xb_add(&bar[XB_XGEN(b.x)], 1u);
            asm volatile("s_waitcnt vmcnt(0)" ::: "memory");
        } else {
            XB_SPIN(xb_ld(&bar[XB_XGEN(b.x)]) == gen, bar);
            __builtin_amdgcn_fence(__ATOMIC_ACQUIRE, "agent");
            asm volatile("s_waitcnt vmcnt(0)" ::: "memory");
        }
    }
    __syncthreads();
}

struct Args { const float* in[16]; float* out; unsigned char* ws; int ph_lo, ph_hi; };
struct Frame {
    LAS unsigned char* lds;
    gu32* ctl;
    int tid, lane, wave;
    int G;
    const __attribute__((address_space(4))) Args* ap;
    GAS float* out; GAS unsigned char* ws;
};
__device__ __forceinline__ GAS bf16* w_ptr(const Frame& F, int L, size_t off) { return (GAS bf16*)(F.ws + WS_W + (size_t)L * W_LAYER + off); }
__device__ __forceinline__ float wave_sum(float v) {
#pragma unroll
    for (int o = 1; o < 64; o <<= 1) v += __shfl_xor(v, o);
    return v;
}
__device__ __forceinline__ s16x4 tr_read(LAS unsigned char* p) { typedef short v4i16_t __attribute__((ext_vector_type(4))); return __builtin_bit_cast(s16x4, __builtin_amdgcn_ds_read_tr16_b64_v4i16((LAS v4i16_t*)p)); }
__device__ __forceinline__ bf16x8 cat8(s16x4 lo, s16x4 hi) { return (bf16x8){lo[0], lo[1], lo[2], lo[3], hi[0], hi[1], hi[2], hi[3]}; }

struct TDesc { const GAS float* src; const GAS float* gk; GAS bf16* dst; int ldw, K; float cmul; };
constexpr int I_IN = 16 * 96, I_OUT = 16 * 32, I_GU = 16 * 176, I_DN = 44 * 32, I_PG = 16 * 32, I_PP = 4 * 32, I_LAYER = I_IN + I_OUT + I_GU + I_DN + I_PG + I_PP;
__device__ __forceinline__ TDesc tr_decode(const Frame& F, int it) {
    const int L = it / I_LAYER; int r = it % I_LAYER; TDesc d;
    if (r < I_IN) { const int kb = r / 96, nb = r % 96, n0 = 32 * nb, k0 = 64 * kb;
        const int sc = n0 < 1536 ? n0 : (n0 < 2048 ? n0 + 16 : ((((n0 - 2048) >> 7) & 1) ? 2576 : 2064) + 128 * ((n0 - 2048) >> 8) + ((n0 - 2048) & 127));
        d.src = ((const GAS float*)F.ap->in[3]) + (size_t)L * DM * IN_DIM + (size_t)k0 * IN_DIM + sc; d.gk = ((const GAS float*)F.ap->in[2]) + L * DM + k0; d.dst = w_ptr(F, L, WO_IN) + (size_t)n0 * 1024 + k0;
        d.ldw = IN_DIM; d.K = 1024; d.cmul = n0 < 256 ? 0.125f : 1.0f; return d; } r -= I_IN;
    if (r < I_OUT) { const int kb = r / 32, nb = r % 32, k0 = 64 * kb;
        d.src = ((const GAS float*)F.ap->in[8]) + (size_t)L * 1024 * 1024 + (size_t)k0 * 1024 + 32 * nb; d.gk = nullptr; d.dst = w_ptr(F, L, WO_OUT) + (size_t)(32 * nb) * 1024 + k0;
        d.ldw = 1024; d.K = 1024; d.cmul = 1.0f; return d; } r -= I_OUT;
    if (r < I_GU) { const int kb = r / 176, nb = r % 176, n0 = 32 * nb, pn = n0 >> 8, bj = (n0 >> 7) & 1, sc = bj * FFN + 128 * pn + (n0 & 127), k0 = 64 * kb;
        d.src = ((const GAS float*)F.ap->in[10]) + (size_t)L * DM * 2 * FFN + (size_t)k0 * 2 * FFN + sc; d.gk = ((const GAS float*)F.ap->in[9]) + L * DM + k0; d.dst = w_ptr(F, L, WO_GU) + (size_t)n0 * 1024 + k0;
        d.ldw = 2 * FFN; d.K = 1024; d.cmul = 1.0f; return d; } r -= I_GU;
    if (r < I_DN) { const int kb = r / 32, nb = r % 32, k0 = 64 * kb;
        d.src = ((const GAS float*)F.ap->in[11]) + (size_t)L * FFN * DM + (size_t)k0 * DM + 32 * nb; d.gk = nullptr; d.dst = w_ptr(F, L, WO_DN) + (size_t)(32 * nb) * FFN + k0;
        d.ldw = DM; d.K = FFN; d.cmul = 1.0f; return d; } r -= I_DN;
    if (r < I_PG) { const int kb = r / 32, nb = r % 32, k0 = 64 * kb;
        d.src = ((const GAS float*)F.ap->in[13]) + (size_t)L * DM * DM + (size_t)k0 * DM + 32 * nb; d.gk = ((const GAS float*)F.ap->in[12]) + L * DM + k0; d.dst = w_ptr(F, L, WO_PG) + (size_t)(32 * nb) * 1024 + k0;
        d.ldw = DM; d.K = 1024; d.cmul = 1.0f; return d; } r -= I_PG;
    { const int kb = r / 32, nb = r % 32, k0 = 64 * kb;
        d.src = ((const GAS float*)F.ap->in[14]) + (size_t)L * PLE * DM + (size_t)k0 * DM + 32 * nb; d.gk = nullptr; d.dst = w_ptr(F, L, WO_PP) + (size_t)(32 * nb) * PLE + k0;
        d.ldw = DM; d.K = PLE; d.cmul = 1.0f; return d; }
}
struct TRegs { f32x4 v[8]; float g[8]; };
__device__ __forceinline__ void tr_load(const TDesc& d, TRegs& R, int lane) {
#pragma unroll
    for (int j = 0; j < 8; ++j) { const int kk = (lane >> 3) + 8 * j; R.v[j] = *(const GAS f32x4*)(d.src + (size_t)kk * d.ldw + 4 * (lane & 7)); R.g[j] = d.gk ? d.gk[kk] : 1.0f; }
}
__device__ __forceinline__ void tr_process(const TDesc& d, const TRegs& R, LAS float* scr, int lane) {
#pragma unroll
    for (int j = 0; j < 8; ++j) { const int kk = (lane >> 3) + 8 * j; const float s = R.g[j] * d.cmul; LAS float* w = scr + kk * 33 + 4 * (lane & 7);
        w[0] = R.v[j][0] * s; w[1] = R.v[j][1] * s; w[2] = R.v[j][2] * s; w[3] = R.v[j][3] * s; }
    LDS_WAIT(); asm volatile("" ::: "memory");
    const int c = lane & 7;
#pragma unroll
    for (int j = 0; j < 4; ++j) { const int n = (lane >> 3) + 8 * j; const LAS float* s = scr + (8 * c) * 33 + n;
        v4u o; o.x = cvt_pk_bf16(s[0 * 33], s[1 * 33]); o.y = cvt_pk_bf16(s[2 * 33], s[3 * 33]); o.z = cvt_pk_bf16(s[4 * 33], s[5 * 33]); o.w = cvt_pk_bf16(s[6 * 33], s[7 * 33]);
        *(GAS v4u*)(d.dst + (size_t)n * d.K + 8 * c) = o; }
    LDS_WAIT(); asm volatile("" ::: "memory");
}
__device__ __forceinline__ void p0_prologue(Frame& F) {
    LAS float* scr = (LAS float*)(F.lds + RING_OFF + F.wave * 16384);
    const int gw = blockIdx.x * NWAVES + F.wave, NGW = F.G * NWAVES;
    { int it = gw; TDesc d; TRegs R;
      if (it < DEPTH * I_LAYER) { d = tr_decode(F, it); tr_load(d, R, F.lane); }
      while (it < DEPTH * I_LAYER) { const int itn = it + NGW; TDesc dn = d; TRegs Rn = R;
          if (itn < DEPTH * I_LAYER) { dn = tr_decode(F, itn); tr_load(dn, Rn, F.lane); }
          tr_process(d, R, scr, F.lane); d = dn; R = Rn; it = itn; } }
    const int gt = blockIdx.x * (NWAVES * 64) + F.tid, NGT = F.G * NWAVES * 64;
    for (int it = gt; it < DEPTH * 256 * 128; it += NGT) {
        const int L = it >> 15, r = it & 32767, n = r >> 7, k0 = (r & 127) * 8;
        const GAS float* win = ((const GAS float*)F.ap->in[3]) + (size_t)L * DM * IN_DIM; const GAS float* wgu = ((const GAS float*)F.ap->in[4]) + (size_t)L * 16 * 256 + n; const GAS float* g1 = ((const GAS float*)F.ap->in[2]) + L * DM;
        float wg[16];
#pragma unroll
        for (int rr = 0; rr < 16; ++rr) wg[rr] = wgu[rr * 256];
        float o[8];
#pragma unroll
        for (int kk = 0; kk < 8; ++kk) { const GAS f32x4* wr_ = (const GAS f32x4*)(win + (size_t)(k0 + kk) * IN_DIM + 1536); float s = 0.f;
#pragma unroll
            for (int rr = 0; rr < 4; ++rr) { const f32x4 w4 = wr_[rr]; s += (w4[0] * wg[4 * rr] + w4[1] * wg[4 * rr + 1]) + (w4[2] * wg[4 * rr + 2] + w4[3] * wg[4 * rr + 3]); }
            o[kk] = s * g1[k0 + kk]; }
        *(GAS v4u*)(w_ptr(F, L, WO_IN) + (size_t)(3072 + n) * 1024 + k0) = pack8(o);
    }
    GAS bf16* HB = (GAS bf16*)(F.ws + WS_HB); GAS float* SSQ0 = (GAS float*)(F.ws + WS_SSQ0);
    for (int m = 2 * gw; m < M; m += 2 * NGW) {
        f32x4 v[2][4]; float s[2] = {0.f, 0.f};
#pragma unroll
        for (int rr = 0; rr < 2; ++rr) { const GAS f32x4* xr = (const GAS f32x4*)(((const GAS float*)F.ap->in[0]) + (size_t)(m + rr) * DM) + F.lane;
#pragma unroll
            for (int j = 0; j < 4; ++j) v[rr][j] = xr[64 * j]; }
#pragma unroll
        for (int rr = 0; rr < 2; ++rr) {
#pragma unroll
            for (int j = 0; j < 4; ++j) s[rr] += (v[rr][j][0] * v[rr][j][0] + v[rr][j][1] * v[rr][j][1]) + (v[rr][j][2] * v[rr][j][2] + v[rr][j][3] * v[rr][j][3]);
            s[rr] = wave_sum(s[rr]);
            GAS v2u* o8 = (GAS v2u*)(HB + (size_t)(m + rr) * DM) + F.lane;
#pragma unroll
            for (int j = 0; j < 4; ++j) { v2u w; w.x = cvt_pk_bf16(v[rr][j][0], v[rr][j][1]); w.y = cvt_pk_bf16(v[rr][j][2], v[rr][j][3]); o8[64 * j] = w; }
            if (F.lane == 0) *(GAS f32x4*)(SSQ0 + (size_t)(m + rr) * 4) = (f32x4){s[rr], 0.f, 0.f, 0.f}; }
    }
    GAS bf16* PB = (GAS bf16*)(F.ws + WS_PB);
    constexpr size_t NP8 = (size_t)DEPTH * M * PLE / 8;
    for (size_t i = (size_t)gt; i < NP8; i += 4 * (size_t)NGT) {
        f32x4 a[4], b[4];
#pragma unroll
        for (int u = 0; u < 4; ++u) { const size_t ii = i + (size_t)u * NGT; if (ii < NP8) { const GAS f32x4* s = (const GAS f32x4*)(F.ap->in[1]) + 2 * ii; a[u] = s[0]; b[u] = s[1]; } }
#pragma unroll
        for (int u = 0; u < 4; ++u) { const size_t ii = i + (size_t)u * NGT; if (ii < NP8) {
            v4u w; w.x = cvt_pk_bf16(a[u][0], a[u][1]); w.y = cvt_pk_bf16(a[u][2], a[u][3]); w.z = cvt_pk_bf16(b[u][0], b[u][1]); w.w = cvt_pk_bf16(b[u][2], b[u][3]);
            *((GAS v4u*)PB + ii) = w; } }
    }
}

__device__ __forceinline__ void gla_prefix(const v4u& la, LAS unsigned char* lds, int wid, int lane, float (&bc)[8], float (&tot)[8]) {
    float c[8]; unpack8(la, c);
#pragma unroll
    for (int off = 8; off < 64; off <<= 1)
#pragma unroll
        for (int j = 0; j < 8; ++j) { const float v = __shfl_up(c[j], off); if (lane >= off) c[j] += v; }
    LAS float* T = (LAS float*)(lds + G_TOT);
    const int d0 = 8 * (lane & 7);
    if (lane >= 56) { *(LAS f32x4*)(T + wid * 64 + d0) = (f32x4){c[0], c[1], c[2], c[3]}; *(LAS f32x4*)(T + wid * 64 + d0 + 4) = (f32x4){c[4], c[5], c[6], c[7]}; }
    LDS_WAIT(); __syncthreads();
    float off[8];
#pragma unroll
    for (int j = 0; j < 8; ++j) { off[j] = 0.f; tot[j] = 0.f; }
#pragma unroll
    for (int w = 0; w < 8; ++w) { const f32x4 a = *(LAS f32x4*)(T + w * 64 + d0), b = *(LAS f32x4*)(T + w * 64 + d0 + 4);
        const float tv[8] = {a[0], a[1], a[2], a[3], b[0], b[1], b[2], b[3]};
#pragma unroll
        for (int j = 0; j < 8; ++j) { tot[j] += tv[j]; if (w < wid) off[j] += tv[j]; } }
#pragma unroll
    for (int j = 0; j < 8; ++j) bc[j] = off[j] + c[j];
}

struct P1Regs { v4u la, kk, vv[2]; };
__device__ __forceinline__ void p1_load(P1Regs& R, const GAS bf16* PROJ, int item, int t, int d0, int tid) {
    const int bh = item >> 7, n = item & 127, b = bh >> 2, h = bh & 3; const size_t tok0 = (size_t)b * SEQ + (size_t)n * CHUNK;
    const GAS bf16* row = PROJ + (tok0 + t) * PS;
    R.la = *(const GAS v4u*)(row + PC_LA + 64 * h + d0);
    R.kk = *(const GAS v4u*)(row + PC_K + 64 * h + d0);
#pragma unroll
    for (int i = 0; i < 2; ++i) R.vv[i] = *(const GAS v4u*)(PROJ + (tok0 + 32 * i + (tid >> 4)) * PS + PC_V + 128 * h + 8 * (tid & 15));
}
__device__ __forceinline__ void gla_p1(Frame& F, int L) {
    const GAS bf16* PROJ = (const GAS bf16*)(F.ws + WS_PROJ); GAS bf16* U = (GAS bf16*)(F.ws + WS_UB); GAS float* DEC = (GAS float*)(F.ws + WS_DECAY);
    LAS unsigned char* lds = F.lds + RING_OFF; const int wid = F.wave, lane = F.lane, tid = F.tid;
    const int t = 8 * wid + (lane >> 3), d0 = 8 * (lane & 7);
    const int r = lane & 31, hh = lane >> 5, g1 = (lane >> 4) & 1, q = (lane & 15) >> 2, p = lane & 3;
    const int dkt = wid >> 2, dvt = wid & 3;
    P1Regs R, Rn;
    if ((int)blockIdx.x < NITEM) p1_load(R, PROJ, blockIdx.x, t, d0, tid);
    if ((int)blockIdx.x + F.G < NITEM) p1_load(Rn, PROJ, blockIdx.x + F.G, t, d0, tid);
    for (int item = blockIdx.x; item < NITEM; item += F.G) {
#pragma unroll
        for (int i = 0; i < 2; ++i) *(LAS v4u*)(lds + G_VT + (32 * i + (tid >> 4)) * V_STRIDE + (tid & 15) * 16) = R.vv[i];
        float bc[8], tot[8]; gla_prefix(R.la, lds, wid, lane, bc, tot);
        float kf[8]; unpack8(R.kk, kf);
#pragma unroll
        for (int j = 0; j < 8; ++j) kf[j] *= fast_exp(tot[j] - bc[j]);
        *(LAS v4u*)(lds + G_KT + t * KD_STRIDE + d0 * 2) = pack8(kf);
        if (tid < 8) { GAS f32x4* dp = (GAS f32x4*)(DEC + (size_t)item * 64 + d0); dp[0] = (f32x4){fast_exp(tot[0]), fast_exp(tot[1]), fast_exp(tot[2]), fast_exp(tot[3])}; dp[1] = (f32x4){fast_exp(tot[4]), fast_exp(tot[5]), fast_exp(tot[6]), fast_exp(tot[7])}; }
        R = Rn;
        if (item + 2 * F.G < NITEM) p1_load(Rn, PROJ, item + 2 * F.G, t, d0, tid);
        LDS_WAIT(); __syncthreads();
        f32x16 acc;
#pragma unroll
        for (int i = 0; i < 16; ++i) acc[i] = 0.f;
#pragma unroll
        for (int ks = 0; ks < 4; ++ks) { const int rw = 16 * ks + 8 * hh + q;
            LAS unsigned char* ap = lds + G_KT + rw * KD_STRIDE + (32 * dkt + 16 * g1 + 4 * p) * 2;
            LAS unsigned char* bp = lds + G_VT + rw * V_STRIDE + (32 * dvt + 16 * g1 + 4 * p) * 2;
            const bf16x8 a = cat8(tr_read(ap), tr_read(ap + 4 * KD_STRIDE)), bb = cat8(tr_read(bp), tr_read(bp + 4 * V_STRIDE));
            acc = __builtin_amdgcn_mfma_f32_32x32x16_bf16(a, bb, acc, 0, 0, 0); }
        { LAS unsigned short* up = (LAS unsigned short*)(lds + G_UT + (32 * dkt + 4 * hh) * U_STRIDE) + 32 * dvt + r;
#pragma unroll
          for (int i = 0; i < 16; i += 2) { const unsigned w = cvt_pk_bf16(acc[i], acc[i + 1]);
              up[((i & 3) + 8 * (i >> 2)) * (U_STRIDE / 2)] = (unsigned short)(w & 0xffffu); up[(((i + 1) & 3) + 8 * ((i + 1) >> 2)) * (U_STRIDE / 2)] = (unsigned short)(w >> 16); } }
        LDS_WAIT(); __syncthreads();
        { const int row = tid >> 3, sg = tid & 7; const LAS v4u* sp = (const LAS v4u*)(lds + G_UT + row * U_STRIDE + sg * 32); const v4u a = sp[0], b2 = sp[1];
          GAS v4u* gp = (GAS v4u*)(U + (size_t)item * 8192 + row * 128 + sg * 16); gp[0] = a; gp[1] = b2; }
    }
}

__device__ __forceinline__ void gla_p2(Frame& F, int L) {
    if (F.wave < 4) {
        const GAS unsigned* U = (const GAS unsigned*)(F.ws + WS_UB); const GAS float* DEC = (const GAS float*)(F.ws + WS_DECAY); GAS unsigned* S = (GAS unsigned*)(F.ws + WS_S);
        for (int e = blockIdx.x * 256 + F.tid; e < BATCH * NH * 4096; e += F.G * 256) {
            const int bh = e >> 12, idx = e & 4095, dk = idx >> 6;
            const GAS unsigned* Up = U + (size_t)bh * NCH * 4096 + idx; const GAS float* dp = DEC + (size_t)bh * NCH * 64 + dk; GAS unsigned* Sp = S + (size_t)bh * NCH * 4096 + idx;
            float s0 = 0.f, s1 = 0.f;
            for (int n0 = 0; n0 < NCH; n0 += 16) {
                unsigned u[16]; float d[16];
#pragma unroll
                for (int i = 0; i < 16; ++i) { u[i] = Up[(size_t)(n0 + i) * 4096]; d[i] = dp[(n0 + i) * 64]; }
#pragma unroll
                for (int i = 0; i < 16; ++i) { Sp[(size_t)(n0 + i) * 4096] = cvt_pk_bf16(s0, s1); s0 = d[i] * s0 + bf_lo(u[i]); s1 = d[i] * s1 + bf_hi(u[i]); }
            }
        }
    } else {
        const GAS bf16* PROJ = (const GAS bf16*)(F.ws + WS_PROJ); GAS bf16* MIX = (GAS bf16*)(F.ws + WS_U);
        const GAS float* cw = ((const GAS float*)F.ap->in[6]) + (size_t)L * 3 * CONVD;
        const int t2 = F.tid - 256, c = 8 * (t2 & 63), tq = t2 >> 6;
        float w0[8], w1[8], w2[8];
        { const f32x4 a = *(const GAS f32x4*)(cw + c), b2 = *(const GAS f32x4*)(cw + c + 4); w0[0] = a[0]; w0[1] = a[1]; w0[2] = a[2]; w0[3] = a[3]; w0[4] = b2[0]; w0[5] = b2[1]; w0[6] = b2[2]; w0[7] = b2[3]; }
        { const f32x4 a = *(const GAS f32x4*)(cw + CONVD + c), b2 = *(const GAS f32x4*)(cw + CONVD + c + 4); w1[0] = a[0]; w1[1] = a[1]; w1[2] = a[2]; w1[3] = a[3]; w1[4] = b2[0]; w1[5] = b2[1]; w1[6] = b2[2]; w1[7] = b2[3]; }
        { const f32x4 a = *(const GAS f32x4*)(cw + 2 * CONVD + c), b2 = *(const GAS f32x4*)(cw + 2 * CONVD + c + 4); w2[0] = a[0]; w2[1] = a[1]; w2[2] = a[2]; w2[3] = a[3]; w2[4] = b2[0]; w2[5] = b2[1]; w2[6] = b2[2]; w2[7] = b2[3]; }
        for (int blk = blockIdx.x; blk < M / 128; blk += F.G) {
            const size_t m0 = (size_t)blk * 128 + 32 * tq;
            float u1[8], u2[8];
            if ((m0 & (SEQ - 1)) == 0) {
#pragma unroll
                for (int j = 0; j < 8; ++j) { u1[j] = 0.f; u2[j] = 0.f; }
            } else {
                const v4u a1 = *(const GAS v4u*)(PROJ + (m0 - 1) * PS + PC_U + c), a2 = *(const GAS v4u*)(PROJ + (m0 - 2) * PS + PC_U + c);
                unpack8(a1, u1); unpack8(a2, u2);
            }
            for (int g0 = 0; g0 < 32; g0 += 8) {
                v4u wu[8], wb[8];
#pragma unroll
                for (int i = 0; i < 8; ++i) { const GAS bf16* rp = PROJ + (m0 + g0 + i) * PS; wu[i] = *(const GAS v4u*)(rp + PC_U + c); wb[i] = *(const GAS v4u*)(rp + PC_CB + c); }
#pragma unroll
                for (int i = 0; i < 8; ++i) { float fu[8], fb[8], y[8]; unpack8(wu[i], fu); unpack8(wb[i], fb);
#pragma unroll
                    for (int j = 0; j < 8; ++j) { const float u0 = fu[j]; y[j] = fb[j] * (w0[j] * u2[j] + w1[j] * u1[j] + w2[j] * u0); u2[j] = u1[j]; u1[j] = u0; }
                    *(GAS v4u*)(MIX + (m0 + g0 + i) * 1024 + 512 + c) = pack8(y); }
            }
        }
    }
}

struct P3Regs { v4u la, qq, kk, vv[2], ss[2], gw[2]; };
__device__ __forceinline__ void p3_load(P3Regs& R, const GAS bf16* PROJ, const GAS bf16* S, int item, int t, int d0, int tid) {
    const int bh = item >> 7, n = item & 127, b = bh >> 2, h = bh & 3; const size_t tok0 = (size_t)b * SEQ + (size_t)n * CHUNK;
    const GAS bf16* row = PROJ + (tok0 + t) * PS;
    R.la = *(const GAS v4u*)(row + PC_LA + 64 * h + d0);
    R.qq = *(const GAS v4u*)(row + PC_Q + 64 * h + d0);
    R.kk = *(const GAS v4u*)(row + PC_K + 64 * h + d0);
#pragma unroll
    for (int i = 0; i < 2; ++i) { R.vv[i] = *(const GAS v4u*)(PROJ + (tok0 + 32 * i + (tid >> 4)) * PS + PC_V + 128 * h + 8 * (tid & 15));
                                  R.ss[i] = *(const GAS v4u*)(S + (size_t)item * 8192 + (size_t)(32 * i + (tid >> 4)) * 128 + 8 * (tid & 15)); }
    const GAS bf16* grow = PROJ + (tok0 + (tid >> 3)) * PS + PC_G + 128 * h + 16 * (tid & 7);
    R.gw[0] = *(const GAS v4u*)(grow); R.gw[1] = *(const GAS v4u*)(grow + 8);
}
__device__ __forceinline__ void gla_p3(Frame& F, int L) {
    const GAS bf16* PROJ = (const GAS bf16*)(F.ws + WS_PROJ); const GAS bf16* S = (const GAS bf16*)(F.ws + WS_S); GAS bf16* MIX = (GAS bf16*)(F.ws + WS_U);
    const GAS float* gn = ((const GAS float*)F.ap->in[7]) + L * DV;
    LAS unsigned char* lds = F.lds + RING_OFF; const int wid = F.wave, lane = F.lane, tid = F.tid;
    const int t = 8 * wid + (lane >> 3), d0 = 8 * (lane & 7);
    const int r = lane & 31, hh = lane >> 5, g1 = (lane >> 4) & 1, q = (lane & 15) >> 2, p = lane & 3;
    const int tt = wid >> 2, dvt = wid & 3;
    f32x4 gnv[4];
#pragma unroll
    for (int i = 0; i < 4; ++i) gnv[i] = *(const GAS f32x4*)(gn + 16 * (tid & 7) + 4 * i);
    P3Regs R, Rn;
    if ((int)blockIdx.x < NITEM) p3_load(R, PROJ, S, blockIdx.x, t, d0, tid);
    if ((int)blockIdx.x + F.G < NITEM) p3_load(Rn, PROJ, S, blockIdx.x + F.G, t, d0, tid);
    for (int item = blockIdx.x; item < NITEM; item += F.G) {
        const int bh = item >> 7, n = item & 127, b = bh >> 2, h = bh & 3; const size_t tok0 = (size_t)b * SEQ + (size_t)n * CHUNK;
#pragma unroll
        for (int i = 0; i < 2; ++i) { *(LAS v4u*)(lds + G_VT + (32 * i + (tid >> 4)) * V_STRIDE + (tid & 15) * 16) = R.vv[i];
                                      *(LAS v4u*)(lds + G_ST + (32 * i + (tid >> 4)) * V_STRIDE + (tid & 15) * 16) = R.ss[i]; }
        float bc[8], tot[8]; gla_prefix(R.la, lds, wid, lane, bc, tot);
        { float qf[8], kf[8]; unpack8(R.qq, qf); unpack8(R.kk, kf);
#pragma unroll
          for (int j = 0; j < 8; ++j) { const float e = fast_exp(bc[j]); qf[j] *= e; kf[j] *= fast_rcp(e); }
          *(LAS v4u*)(lds + G_QT + t * QK_STRIDE + d0 * 2) = pack8(qf);
          *(LAS v4u*)(lds + G_KT + t * QK_STRIDE + d0 * 2) = pack8(kf); }
        const v4u gw0 = R.gw[0], gw1 = R.gw[1];
        R = Rn;
        if (item + 2 * F.G < NITEM) p3_load(Rn, PROJ, S, item + 2 * F.G, t, d0, tid);
        LDS_WAIT(); __syncthreads();
        f32x16 o;
#pragma unroll
        for (int i = 0; i < 16; ++i) o[i] = 0.f;
        bf16x8 qfr[4];
#pragma unroll
        for (int ks = 0; ks < 4; ++ks) qfr[ks] = *(LAS bf16x8*)(lds + G_QT + (32 * tt + r) * QK_STRIDE + (16 * ks + 8 * hh) * 2);
#pragma unroll
        for (int ks = 0; ks < 4; ++ks) { LAS unsigned char* bp = lds + G_ST + (16 * ks + 8 * hh + q) * V_STRIDE + (32 * dvt + 16 * g1 + 4 * p) * 2;
            const bf16x8 sb = cat8(tr_read(bp), tr_read(bp + 4 * V_STRIDE));
            o = __builtin_amdgcn_mfma_f32_32x32x16_bf16(qfr[ks], sb, o, 0, 0, 0); }
        for (int st = 0; st <= tt; ++st) {
            f32x16 x;
#pragma unroll
            for (int i = 0; i < 16; ++i) x[i] = 0.f;
#pragma unroll
            for (int ks = 0; ks < 4; ++ks) { const bf16x8 ka = *(LAS bf16x8*)(lds + G_KT + (32 * st + r) * QK_STRIDE + (16 * ks + 8 * hh) * 2);
                x = __builtin_amdgcn_mfma_f32_32x32x16_bf16(ka, qfr[ks], x, 0, 0, 0); }
            if (st == tt) {
#pragma unroll
                for (int i = 0; i < 16; ++i) { const int sl = (i & 3) + 8 * (i >> 2) + 4 * hh; if (sl > r) x[i] = 0.f; } }
#pragma unroll
            for (int k2 = 0; k2 < 2; ++k2) {
                v4u pw; pw.x = cvt_pk_bf16(x[8 * k2 + 0], x[8 * k2 + 1]); pw.y = cvt_pk_bf16(x[8 * k2 + 2], x[8 * k2 + 3]); pw.z = cvt_pk_bf16(x[8 * k2 + 4], x[8 * k2 + 5]); pw.w = cvt_pk_bf16(x[8 * k2 + 6], x[8 * k2 + 7]);
                LAS unsigned char* bp = lds + G_VT + (32 * st + 16 * k2 + 4 * hh + q) * V_STRIDE + (32 * dvt + 16 * g1 + 4 * p) * 2;
                const bf16x8 vb = cat8(tr_read(bp), tr_read(bp + 8 * V_STRIDE));
                o = __builtin_amdgcn_mfma_f32_32x32x16_bf16(__builtin_bit_cast(bf16x8, pw), vb, o, 0, 0, 0); }
        }
        { LAS float* op = (LAS float*)(lds + G_OST + (32 * tt + 4 * hh) * OST_STRIDE) + 32 * dvt + r;
#pragma unroll
          for (int i = 0; i < 16; ++i) op[((i & 3) + 8 * (i >> 2)) * (OST_STRIDE / 4)] = o[i]; }
        LDS_WAIT(); __syncthreads();
        { const int trw = tid >> 3, sg = tid & 7; const LAS f32x4* op = (const LAS f32x4*)(lds + G_OST + trw * OST_STRIDE + sg * 64);
          f32x4 ov[4]; float ssq = 0.f;
#pragma unroll
          for (int i = 0; i < 4; ++i) { ov[i] = op[i]; ssq += (ov[i][0] * ov[i][0] + ov[i][1] * ov[i][1]) + (ov[i][2] * ov[i][2] + ov[i][3] * ov[i][3]); }
          ssq += __shfl_xor(ssq, 1); ssq += __shfl_xor(ssq, 2); ssq += __shfl_xor(ssq, 4);
          const float rs = __builtin_amdgcn_rsqf(ssq * (1.0f / DV) + pg8::RMS_EPS);
          float gf[16]; { float a8[8]; unpack8(gw0, a8);
#pragma unroll
              for (int j = 0; j < 8; ++j) gf[j] = a8[j];
              unpack8(gw1, a8);
#pragma unroll
              for (int j = 0; j < 8; ++j) gf[8 + j] = a8[j]; }
          float res[16];
#pragma unroll
          for (int i = 0; i < 4; ++i)
#pragma unroll
              for (int j = 0; j < 4; ++j) res[4 * i + j] = ov[i][j] * rs * gnv[i][j] * siluf_(gf[4 * i + j]);
          GAS bf16* mrow = MIX + (tok0 + trw) * 1024 + 128 * h + 16 * sg;
          { float a8[8];
#pragma unroll
            for (int j = 0; j < 8; ++j) a8[j] = res[j];
            *(GAS v4u*)(mrow) = pack8(a8);
#pragma unroll
            for (int j = 0; j < 8; ++j) a8[j] = res[8 + j];
            *(GAS v4u*)(mrow + 8) = pack8(a8); } }
    }
}

__device__ __forceinline__ void final_norm(Frame& F, const GAS float* ssq) {
    const int gw = blockIdx.x * NWAVES + F.wave, NGW = F.G * NWAVES;
    static_assert((DEPTH & 1) == 0, "the final residual stream must sit in d_ws (buffer 0), not in d_out");
    const GAS bf16* HB = (const GAS bf16*)(F.ws + WS_HB);
    f32x4 gv[4];
#pragma unroll
    for (int j = 0; j < 2; ++j) { gv[2 * j] = *((const GAS f32x4*)(((const GAS float*)F.ap->in[15]) + 512 * j + 8 * F.lane)); gv[2 * j + 1] = *((const GAS f32x4*)(((const GAS float*)F.ap->in[15]) + 512 * j + 8 * F.lane + 4)); }
    for (int m = gw; m < M; m += NGW) {
        const float rs = pg8::rstd_from(ssq, m);
        const GAS bf16* hr = HB + (size_t)m * DM + 8 * F.lane; GAS float* orow = F.out + (size_t)m * DM + 8 * F.lane;
#pragma unroll
        for (int j = 0; j < 2; ++j) { const v4u w = *(const GAS v4u*)(hr + 512 * j); float f[8]; unpack8(w, f);
            *(GAS f32x4*)(orow + 512 * j) = (f32x4){f[0], f[1], f[2], f[3]} * rs * gv[2 * j];
            *(GAS f32x4*)(orow + 512 * j + 4) = (f32x4){f[4], f[5], f[6], f[7]} * rs * gv[2 * j + 1]; }
    }
}

#ifndef REP_KIND
#define REP_KIND -1
#define REP_N 1
#endif
#ifndef STAGGER_TICKS
#define STAGGER_TICKS 0
#endif
#define STAGGER() do { if (STAGGER_TICKS > 0 && ((blockIdx.x >> 3) & 1)) { const unsigned long long t0_ = __builtin_amdgcn_s_memrealtime(); while (__builtin_amdgcn_s_memrealtime() - t0_ < (unsigned long long)STAGGER_TICKS) __builtin_amdgcn_s_sleep(8); } } while (0)
#ifndef PH_MASK
#define PH_MASK 4095
#endif
__global__ void __launch_bounds__(NWAVES * 64, 2) mega_fwd(Args args) {
    extern __shared__ __attribute__((aligned(16))) unsigned char lds[];
    Frame F;
    F.lds = (LAS unsigned char*)lds;
    F.tid = threadIdx.x; F.lane = F.tid & 63; F.wave = __builtin_amdgcn_readfirstlane(F.tid >> 6);
    F.G = gridDim.x;
    F.ws = (GAS unsigned char*)args.ws; F.out = (GAS float*)args.out; F.ctl = (gu32*)(args.ws + WS_CTL);
    F.ap = (const __attribute__((address_space(4))) Args*)__builtin_amdgcn_kernarg_segment_ptr();
    for (int u = F.tid; u < (LDS_BYTES - LDSCTL_OFF) / 4; u += NWAVES * 64) ((LAS unsigned*)(F.lds + LDSCTL_OFF))[u] = 0u;
    __syncthreads();
    const int lo = args.ph_lo, hi = args.ph_hi;
    XcdBarrier bar; bar.bar = (unsigned*)(F.ctl + CW_BAR); bar.x = 0; bar.st = (volatile LAS unsigned*)(F.lds + MISC_OFF + 32);
    if (hi - lo > 1) bar = xcd_barrier_post((unsigned*)(F.ctl + CW_BAR), (volatile LAS unsigned*)(F.lds + MISC_OFF + 32));

    PG8_LAS float* escr = (PG8_LAS float*)(F.lds + EPI_SCR_OFF); PG8_LAS unsigned char* rtab = F.lds + RSTD_TAB_OFF;

    for (int ph = lo; ph < hi; ++ph) {
        const int kind_ = (ph == 0) ? 100 : (ph == N_PHASES - 1) ? 101 : ((ph - 1) & 7);
        #ifdef PROBE_ZERO_D
        const int nrep = (kind_ == REP_KIND && ph <= 8) ? REP_N : 1;
#elif defined(PROBE_NULL_C)
        const int nrep = (kind_ == REP_KIND) ? REP_N : 1;
#else
        const int nrep = (kind_ == REP_KIND && !(kind_ == 4 && ph > 8)) ? REP_N : 1;
#endif
        for (int rep = 0; rep < nrep; ++rep) {
        { int t_ = threadIdx.x; asm volatile("" : "+v"(t_)); F.tid = t_; F.lane = t_ & 63; F.wave = __builtin_amdgcn_readfirstlane(t_ >> 6);
          const __attribute__((address_space(4))) Args* a_ = (const __attribute__((address_space(4))) Args*)__builtin_amdgcn_kernarg_segment_ptr(); asm volatile("" : "+s"(a_)); F.ap = a_;
          GAS unsigned char* w_ = (GAS unsigned char*)args.ws; asm volatile("" : "+s"(w_)); F.ws = w_; GAS float* o_ = (GAS float*)args.out; asm volatile("" : "+s"(o_)); F.out = o_; }
        GAS bf16* HB0 = (GAS bf16*)(F.ws + WS_HB); GAS bf16* HB1 = (GAS bf16*)F.out + (size_t)M * DM; GAS bf16* PROJ = (GAS bf16*)(F.ws + WS_PROJ); GAS bf16* MIX = (GAS bf16*)(F.ws + WS_U); GAS bf16* PB = (GAS bf16*)(F.ws + WS_PB);
        GAS float* SSQ[2] = {(GAS float*)(F.ws + WS_SSQ0), (GAS float*)(F.ws + WS_SSQ1)};
        if (ph == 0) { if (PH_MASK & 1) p0_prologue(F); }
        else if (ph == N_PHASES - 1) { if (PH_MASK & 2) final_norm(F, SSQ[0]); }
        else {
            const int L = (ph - 1) >> 3, s = (ph - 1) & 7;
            GAS float* sA = SSQ[L & 1]; GAS float* sB = SSQ[(L & 1) ^ 1];
            GAS bf16* HB = (L & 1) ? HB1 : HB0; GAS bf16* HBN = (L & 1) ? HB0 : HB1;
            if (s == 0) { if (PH_MASK & 4) {
                pg8::Gemm g{(const bf16*)HB, (const bf16*)w_ptr(F, L, WO_IN), M, NPROJ, 1024}; pg8::RstdOrder S; S.init(M, NPROJ, F.G, (int)blockIdx.x); S.ssq = sA; S.tab = rtab; S.tid = F.tid; S.cnt = 0;
                STAGGER();
                pg8::EpiProj E{PROJ, PS, rtab, ((const GAS float*)F.ap->in[5]) + L * 256, 0};
#ifdef PROBE_NULL_A
                if (rep + 1 < nrep) { pg8::EpiNull E0; pg8::gemm_phase<pg8::EpiNull, pg8::RstdOrder, true, true>(F.lds + RING_OFF, g, S, E0, F.tid); } else
#endif
                pg8::gemm_phase<pg8::EpiProj, pg8::RstdOrder, true, true>(F.lds + RING_OFF, g, S, E, F.tid); }
                { int t_ = F.tid; asm volatile("" : "+v"(t_)); F.tid = t_; }
                if (PH_MASK & 1024) { int kp_ = PLE; asm volatile("" : "+s"(kp_)); pg8::Gemm g{(const bf16*)(PB + (size_t)L * M * PLE), (const bf16*)w_ptr(F, L, WO_PP), M, 1024, kp_};
                  pg8::PPOrder S{F.G, (int)blockIdx.x}; pg8::EpiPP E{(GAS bf16*)F.out, 1024};
                  pg8::gemm_phase<pg8::EpiPP, pg8::PPOrder, true, true>(F.lds + RING_OFF, g, S, E, F.tid); }
            } else if (s == 1) { if (PH_MASK & 8) gla_p1(F, L); }
            else if (s == 2) { if (PH_MASK & 16) gla_p2(F, L); }
            else if (s == 3) { if (PH_MASK & 32) gla_p3(F, L); }
            else if (s == 4) { if (PH_MASK & 64) {
                pg8::Gemm g{(const bf16*)MIX, (const bf16*)w_ptr(F, L, WO_OUT), M, 1024, 1024}; pg8::StaticOrder S; S.init(M, 1024, F.G, (int)blockIdx.x);
                pg8::EpiRes<0> E{nullptr, HB, HB, sB, rtab, nullptr, escr, F.tid, 0};
#ifdef PROBE_NULL_C
                if (rep + 1 < nrep) { pg8::EpiNull E0; pg8::gemm_phase<pg8::EpiNull, pg8::StaticOrder, true, true>(F.lds + RING_OFF, g, S, E0, F.tid); } else
#endif
                pg8::gemm_phase<pg8::EpiRes<0>, pg8::StaticOrder, true, true>(F.lds + RING_OFF, g, S, E, F.tid); }
            } else if (s == 5) { if (PH_MASK & 128) {
                pg8::Gemm g{(const bf16*)HB, (const bf16*)w_ptr(F, L, WO_GU), M, 2 * FFN, 1024}; pg8::RstdOrder S; S.init(M, 2 * FFN, F.G, (int)blockIdx.x); S.ssq = sB; S.tab = rtab; S.tid = F.tid; S.cnt = 0;
                STAGGER();
#if defined(PROBE_ZERO_D) && PROBE_ZERO_D == 1
                if (rep + 1 < nrep) g.A = (const bf16*)HB1;
#endif
                pg8::EpiSwiGLU E{PROJ, FFN, rtab, 0};
#ifdef PROBE_NORS_D
                if (rep + 1 < nrep) { pg8::EpiSwiGLU_<true> E0{PROJ, FFN, rtab, 0}; pg8::gemm_phase<pg8::EpiSwiGLU_<true>, pg8::RstdOrder, true, true>(F.lds + RING_OFF, g, S, E0, F.tid); } else
#endif
                pg8::gemm_phase<pg8::EpiSwiGLU, pg8::RstdOrder, true, true>(F.lds + RING_OFF, g, S, E, F.tid); }
            } else if (s == 6) { if (PH_MASK & 256) {
                pg8::Gemm g{(const bf16*)PROJ, (const bf16*)w_ptr(F, L, WO_DN), M, 1024, FFN}; pg8::StaticOrder S; S.init(M, 1024, F.G, (int)blockIdx.x);
                pg8::EpiRes<0> E{nullptr, HB, HB, sA, rtab, nullptr, escr, F.tid, 0};
#ifdef PROBE_NULL_E
                if (rep + 1 < nrep) { pg8::EpiNull E0; pg8::gemm_phase<pg8::EpiNull, pg8::StaticOrder, true, true>(F.lds + RING_OFF, g, S, E0, F.tid); } else
#endif
                pg8::gemm_phase<pg8::EpiRes<0>, pg8::StaticOrder, true, true>(F.lds + RING_OFF, g, S, E, F.tid); }
            } else { if (PH_MASK & 512) {
                if (PH_MASK & 2048) { pg8::Gemm g{(const bf16*)HB, (const bf16*)w_ptr(F, L, WO_PG), M, 1024, 1024}; pg8::RstdOrder S; S.init(M, 1024, F.G, (int)blockIdx.x); S.ssq = sA; S.tab = rtab; S.tid = F.tid; S.cnt = 0;
                  pg8::EpiRes<1> E{nullptr, HB, HBN, sB, rtab, (const GAS bf16*)F.out, escr, F.tid, 0};
#ifdef PROBE_NULL_F
                  if (rep + 1 < nrep) { pg8::EpiNull E0; pg8::gemm_phase<pg8::EpiNull, pg8::RstdOrder, true, true>(F.lds + RING_OFF, g, S, E0, F.tid); } else
#endif
                  pg8::gemm_phase<pg8::EpiRes<1>, pg8::RstdOrder, true, true>(F.lds + RING_OFF, g, S, E, F.tid); } }
            }
        }
        if (rep + 1 < nrep) xcd_barrier(bar);
        }
        if (ph + 1 < hi) xcd_barrier(bar);
#ifdef PROBE_XBAR
        if (ph + 1 < hi) { xcd_barrier(bar); xcd_barrier(bar); }
#endif
    }
}

#ifndef MK_ONE_LAUNCH
#define MK_ONE_LAUNCH 1
#endif
extern "C" void kernel_launch(void* const* d_in, const int* in_sizes, int n_in, void* d_out, int out_size, void* d_ws, size_t ws_size, hipStream_t stream) {
    static int grid = 0;
    if (grid == 0) {
        if (n_in != 16 || in_sizes[0] != M * DM || out_size != M * DM || ws_size < WS_END) { fprintf(stderr, "kernel_launch: unexpected shapes / workspace (%d inputs, in0 %d, out %d, ws %zu)\n", n_in, n_in > 0 ? in_sizes[0] : -1, out_size, ws_size); grid = -1; return; }
        int dev = 0, cus = 0, per_cu = 0;
        if (hipGetDevice(&dev) != hipSuccess || hipDeviceGetAttribute(&cus, hipDeviceAttributeMultiprocessorCount, dev) != hipSuccess) { grid = -1; return; }
        if (hipFuncSetAttribute((const void*)mega_fwd, hipFuncAttributeMaxDynamicSharedMemorySize, LDS_BYTES) != hipSuccess) { fprintf(stderr, "kernel_launch: hipFuncSetAttribute failed\n"); grid = -1; return; }
        if (hipOccupancyMaxActiveBlocksPerMultiprocessor(&per_cu, (const void*)mega_fwd, NWAVES * 64, LDS_BYTES) != hipSuccess || per_cu < 1) { fprintf(stderr, "kernel_launch: occupancy query says %d blocks per CU\n", per_cu); (void)hipGetLastError(); grid = -1; return; }
        grid = cus;
    }
    if (grid < 0) return;
    (void)hipMemsetAsync((char*)d_ws + WS_CTL, 0, CTL_ZERO_BYTES, stream);
#ifdef PROBE_ZERO_D
    (void)hipMemsetAsync((char*)d_out + (size_t)M * DM * 2, 0, (size_t)M * DM * 2, stream);
#endif
    Args a{};
    for (int i = 0; i < 16; ++i) a.in[i] = (const float*)d_in[i];
    a.out = (float*)d_out; a.ws = (unsigned char*)d_ws;
#if MK_ONE_LAUNCH
    a.ph_lo = 0; a.ph_hi = N_PHASES;
    void* kargs[] = {&a};
    hipError_t e = hipLaunchCooperativeKernel((const void*)mega_fwd, dim3(grid), dim3(NWAVES * 64), kargs, LDS_BYTES, stream);
    if (e != hipSuccess) fprintf(stderr, "kernel_launch: cooperative launch failed: %s (grid %d)\n", hipGetErrorString(e), grid);
#else
    for (int ph = 0; ph < N_PHASES; ++ph) { a.ph_lo = ph; a.ph_hi = ph + 1; hipLaunchKernelGGL(mega_fwd, dim3(grid), dim3(NWAVES * 64), LDS_BYTES, stream, a); }
#endif
}
```

```cpp
#include <hip/hip_runtime.h>
#include <cstdio>
#include <cstdint>
namespace pg8 {
#define PG8_LAS __attribute__((address_space(3)))
typedef unsigned short bf16_t;
typedef short bf16x8 __attribute__((ext_vector_type(8)));
typedef float f32x4 __attribute__((ext_vector_type(4)));
typedef unsigned u32x4 __attribute__((ext_vector_type(4)));
constexpr int BM = 256, BK = 64, HALF = 128, HTB = HALF * BK * 2  , STAGE_BYTES = 8 * HTB, NXCD = 8, WGM = 8;

__host__ __device__ __forceinline__ int lds_byte(int r, int c) { const int st = (r >> 4) * 2 + (c >> 5), rr = r & 15, cc = c & 31, ob = rr * 64 + cc * 2; return st * 1024 + (ob ^ (((ob >> 9) & 1) << 5)); }
__host__ __device__ __forceinline__ void stage_rc(int b, int& R, int& C) { const int st = b / 1024, sb = b % 1024, swz = sb ^ (((sb >> 9) & 1) << 5); R = (st >> 1) * 16 + swz / 64; C = (st & 1) * 32 + (swz % 64) / 2; }
__host__ __device__ __forceinline__ int perm32(int rho) { const int n = rho >> 4, i = rho & 15; return 8 * (i >> 2) + 4 * n + (i & 3); }

struct Unit { int pm, pn; };
struct Gemm { const bf16_t* A; const bf16_t* Bt; int M, N, K; };

struct StaticOrder {
    int nM, nN, nwg, G, c;
    __host__ __device__ void init(int M, int N, int G_, int c_) { nM = M / BM; nN = N / BM; nwg = nM * nN; G = G_; c = c_; }
    __host__ __device__ bool next(int i, Unit& u) const {
        const long L = (long)i * G + c; if (L >= nwg) return false;
        int wgid = (int)L; { const int q = nwg / NXCD, r = nwg % NXCD, xcd = wgid % NXCD, off = wgid / NXCD; wgid = (xcd < r ? xcd * (q + 1) : r * (q + 1) + (xcd - r) * q) + off; }
        const int nig = WGM * nN, gid = wgid / nig, fm = gid * WGM, gsz = (nM - fm) < WGM ? (nM - fm) : WGM;
        u.pm = fm + ((wgid % nig) % gsz); u.pn = (wgid % nig) / gsz; return true;
    }
    __device__ __forceinline__ void a_ready(const Unit&) const {}
    __device__ __forceinline__ void done(const Unit&) const {}
};


typedef float f32x2_cv __attribute__((ext_vector_type(2))); typedef __bf16 bf16x2_cv __attribute__((ext_vector_type(2)));
__device__ __forceinline__ unsigned cvt_pk_bf16(float lo, float hi) { const f32x2_cv v = {lo, hi}; const bf16x2_cv b = __builtin_convertvector(v, bf16x2_cv); return __builtin_bit_cast(unsigned, b); }
typedef unsigned u32x2 __attribute__((ext_vector_type(2)));
#define PG8_GAS __attribute__((address_space(1)))
constexpr float RMS_EPS = 1e-6f;
__device__ __forceinline__ float fast_rcp(float x) { return __builtin_amdgcn_rcpf(x); }
__device__ __forceinline__ float fast_exp(float x) { return __builtin_amdgcn_exp2f(x * 1.4426950408889634f); }
__device__ __forceinline__ float fast_log(float x) { return __builtin_amdgcn_logf(x) * 0.6931471805599453f; }
__device__ __forceinline__ float sigmoidf_(float x) { return fast_rcp(1.0f + fast_exp(-x)); }
__device__ __forceinline__ float siluf_(float x) { return x * sigmoidf_(x); }
__device__ __forceinline__ float logsig16(float x) { return (fminf(x, 0.f) - fast_log(1.0f + fast_exp(-fabsf(x)))) * 0.0625f; }
__device__ __forceinline__ float rstd_from(const PG8_GAS float* ssq, int row) { const f32x4 s = *(const PG8_GAS f32x4*)(ssq + (size_t)row * 4); return __builtin_amdgcn_rsqf(((s[0] + s[1]) + (s[2] + s[3])) * (1.0f / 1024.0f) + RMS_EPS); }

__device__ __forceinline__ float rstd_tab(const PG8_LAS unsigned char* tab, int par, int rl) { const f32x4 s = *(const PG8_LAS f32x4*)(tab + par * 4096 + rl * 16); return __builtin_amdgcn_rsqf(((s[0] + s[1]) + (s[2] + s[3])) * (1.0f / 1024.0f) + RMS_EPS); }
struct RstdOrder : StaticOrder {
    const PG8_GAS float* ssq; PG8_LAS unsigned char* tab; int tid; mutable int cnt;
    __device__ __forceinline__ void a_ready(const Unit& u) const {
        const int w = __builtin_amdgcn_readfirstlane(tid >> 6);
        if (w < 4) __builtin_amdgcn_global_load_lds((const unsigned*)(ssq + (size_t)(u.pm * BM + tid) * 4), (PG8_LAS unsigned*)(tab + (cnt & 1) * 4096 + w * 1024), 16, 0, 0);
        ++cnt;
    }
};
struct EpiProj {
    static constexpr bool PERM = true, AFTER_DRAIN = false;
    PG8_GAS bf16_t* O; int ldc; const PG8_LAS unsigned char* tab; const PG8_GAS float* bgate; mutable int ui;
    __device__ __forceinline__ void operator()(const f32x4 (&acc)[2][2][4][2], const Unit& u, int wr, int wc, int fr, int fq) const {
        const int row0 = u.pm * BM + wr * 64 + fr, rl0 = wr * 64 + fr, par = ui & 1; ++ui;
        const int kind = (u.pn == 12) ? 2 : (u.pn >= 8 ? 1 : 0);
        if (kind == 1) {
            const int col0 = 2048 + (u.pn - 8) * HALF + wc * 32 + 8 * fq;
#pragma unroll
            for (int ai = 0; ai < 2; ++ai)
#pragma unroll
                for (int m = 0; m < 4; ++m) { const int row = row0 + ai * HALF + m * 16; const float rs = rstd_tab(tab, par, rl0 + ai * HALF + m * 16), rs2 = rs * rs;
                    const f32x4 h0 = acc[ai][0][m][0] * acc[ai][1][m][0] * rs2, h1 = acc[ai][0][m][1] * acc[ai][1][m][1] * rs2;
                    u32x4 w; w.x = cvt_pk_bf16(h0[0], h0[1]); w.y = cvt_pk_bf16(h0[2], h0[3]); w.z = cvt_pk_bf16(h1[0], h1[1]); w.w = cvt_pk_bf16(h1[2], h1[3]);
                    *(PG8_GAS u32x4*)(O + (size_t)row * ldc + col0) = w; }
            return;
        }
        const bool isg = (kind == 2);
        const int col0 = (isg ? 2560 : u.pn * BM) + wc * 32 + 8 * fq;
        f32x4 bv[2][2];
#pragma unroll
        for (int bj = 0; bj < 2; ++bj)
#pragma unroll
            for (int n = 0; n < 2; ++n) bv[bj][n] = isg ? *(const PG8_GAS f32x4*)(bgate + wc * 32 + 8 * fq + bj * HALF + 4 * n) : (f32x4){0.f, 0.f, 0.f, 0.f};
#pragma unroll
        for (int ai = 0; ai < 2; ++ai)
#pragma unroll
            for (int m = 0; m < 4; ++m) { const int row = row0 + ai * HALF + m * 16; const float rs = rstd_tab(tab, par, rl0 + ai * HALF + m * 16); PG8_GAS bf16_t* rowp = O + (size_t)row * ldc + col0;
#pragma unroll
                for (int bj = 0; bj < 2; ++bj) { f32x4 v0 = acc[ai][bj][m][0] * rs, v1 = acc[ai][bj][m][1] * rs;
                    if (isg) { v0 = v0 + bv[bj][0]; v1 = v1 + bv[bj][1];
#pragma unroll
                        for (int i = 0; i < 4; ++i) { v0[i] = logsig16(v0[i]); v1[i] = logsig16(v1[i]); } }
                    u32x4 w; w.x = cvt_pk_bf16(v0[0], v0[1]); w.y = cvt_pk_bf16(v0[2], v0[3]); w.z = cvt_pk_bf16(v1[0], v1[1]); w.w = cvt_pk_bf16(v1[2], v1[3]);
                    *(PG8_GAS u32x4*)(rowp + bj * HALF) = w; } }
    }
};
template <bool NORS = false> struct EpiSwiGLU_ {
    static constexpr bool PERM = true, AFTER_DRAIN = false;
    PG8_GAS bf16_t* O; int ldc; const PG8_LAS unsigned char* tab; mutable int ui;
    __device__ __forceinline__ void operator()(const f32x4 (&acc)[2][2][4][2], const Unit& u, int wr, int wc, int fr, int fq) const {
        const int row0 = u.pm * BM + wr * 64 + fr, col0 = u.pn * HALF + wc * 32 + 8 * fq, rl0 = wr * 64 + fr, par = ui & 1; ++ui;
#pragma unroll
        for (int ai = 0; ai < 2; ++ai)
#pragma unroll
            for (int m = 0; m < 4; ++m) { const int row = row0 + ai * HALF + m * 16; const float rs = NORS ? 1.0f : rstd_tab(tab, par, rl0 + ai * HALF + m * 16); const float k1 = rs * -1.4426950408889634f, k2 = rs * rs;
                f32x4 h0, h1;
                { const f32x4 a = acc[ai][0][m][0], b = acc[ai][1][m][0]; const f32x4 num = a * b * k2, ex = a * k1;
#pragma unroll
                  for (int i = 0; i < 4; ++i) h0[i] = num[i] * fast_rcp(1.0f + __builtin_amdgcn_exp2f(ex[i])); }
                { const f32x4 a = acc[ai][0][m][1], b = acc[ai][1][m][1]; const f32x4 num = a * b * k2, ex = a * k1;
#pragma unroll
                  for (int i = 0; i < 4; ++i) h1[i] = num[i] * fast_rcp(1.0f + __builtin_amdgcn_exp2f(ex[i])); }
                u32x4 w; w.x = cvt_pk_bf16(h0[0], h0[1]); w.y = cvt_pk_bf16(h0[2], h0[3]); w.z = cvt_pk_bf16(h1[0], h1[1]); w.w = cvt_pk_bf16(h1[2], h1[3]);
                *(PG8_GAS u32x4*)(O + (size_t)row * ldc + col0) = w; }
    }
};
typedef EpiSwiGLU_<false> EpiSwiGLU;
struct EpiPP {
    static constexpr bool PERM = true, AFTER_DRAIN = false;
    PG8_GAS bf16_t* O; int ldc;
    __device__ __forceinline__ void operator()(const f32x4 (&acc)[2][2][4][2], const Unit& u, int wr, int wc, int fr, int fq) const {
        const int row0 = u.pm * BM + wr * 64 + fr, col0 = u.pn * BM + wc * 32 + 8 * fq;
#pragma unroll
        for (int ai = 0; ai < 2; ++ai)
#pragma unroll
            for (int m = 0; m < 4; ++m) { PG8_GAS bf16_t* rowp = O + (size_t)(row0 + ai * HALF + m * 16) * ldc + col0;
#pragma unroll
                for (int bj = 0; bj < 2; ++bj) { const f32x4 v0 = acc[ai][bj][m][0], v1 = acc[ai][bj][m][1];
                    u32x4 w; w.x = cvt_pk_bf16(v0[0], v0[1]); w.y = cvt_pk_bf16(v0[2], v0[3]); w.z = cvt_pk_bf16(v1[0], v1[1]); w.w = cvt_pk_bf16(v1[2], v1[3]);
                    *(PG8_GAS u32x4*)(rowp + bj * HALF) = w; } }
    }
};
template <int MODE> struct EpiRes {
    static constexpr bool PERM = false, AFTER_DRAIN = false;
    const PG8_GAS float* basef; const PG8_GAS bf16_t* hbin; PG8_GAS bf16_t* hb; PG8_GAS float* ssq_out; const PG8_LAS unsigned char* tab; const PG8_GAS bf16_t* pp; PG8_LAS float* scr; int tid; mutable int ui;
    __device__ __forceinline__ void operator()(const f32x4 (&acc_)[2][2][4][2], const Unit& u, int wr, int wc, int fr, int fq) const {
        f32x4 (&acc)[2][2][4][2] = const_cast<f32x4 (&)[2][2][4][2]>(acc_);
        const int col0 = u.pn * BM + wc * 32 + 4 * fq, par = ui & 1; ++ui;
#pragma unroll
        for (int ai = 0; ai < 2; ++ai) {
            u32x2 bw[4][2][2], pw[4][2][2];
#pragma unroll
            for (int m = 0; m < 4; ++m) { const size_t off = (size_t)(u.pm * BM + ai * HALF + wr * 64 + m * 16 + fr) * 1024 + col0;
#pragma unroll
                for (int bj = 0; bj < 2; ++bj)
#pragma unroll
                    for (int n = 0; n < 2; ++n) { const size_t c = off + bj * HALF + n * 16;
                        if (MODE == 1) pw[m][bj][n] = *(const PG8_GAS u32x2*)(pp + c);
                        bw[m][bj][n] = *(const PG8_GAS u32x2*)(hbin + c); } }
#pragma unroll
            for (int m = 0; m < 4; ++m) { const int rl = ai * HALF + wr * 64 + m * 16 + fr; const size_t off = (size_t)(u.pm * BM + rl) * 1024 + col0;
                float rs = 1.0f; if (MODE == 1) rs = rstd_tab(tab, par, rl) * -1.4426950408889634f;
                float part = 0.f;
#pragma unroll
                for (int bj = 0; bj < 2; ++bj)
#pragma unroll
                    for (int n = 0; n < 2; ++n) { const size_t c = off + bj * HALF + n * 16; f32x4 v = acc[ai][bj][m][n];
                        if (MODE == 1) { const u32x2 q = pw[m][bj][n];
                            v[0] = __uint_as_float(q.x << 16) * fast_rcp(1.0f + __builtin_amdgcn_exp2f(v[0] * rs)); v[1] = __uint_as_float(q.x & 0xffff0000u) * fast_rcp(1.0f + __builtin_amdgcn_exp2f(v[1] * rs));
                            v[2] = __uint_as_float(q.y << 16) * fast_rcp(1.0f + __builtin_amdgcn_exp2f(v[2] * rs)); v[3] = __uint_as_float(q.y & 0xffff0000u) * fast_rcp(1.0f + __builtin_amdgcn_exp2f(v[3] * rs)); }
                        const u32x2 b2 = bw[m][bj][n]; f32x4 b; b[0] = __uint_as_float(b2.x << 16); b[1] = __uint_as_float(b2.x & 0xffff0000u); b[2] = __uint_as_float(b2.y << 16); b[3] = __uint_as_float(b2.y & 0xffff0000u);
                        const f32x4 o = b + v;
                        { u32x2 w; w.x = cvt_pk_bf16(o[0], o[1]); w.y = cvt_pk_bf16(o[2], o[3]); *(PG8_GAS u32x2*)(hb + c) = w; }
                        part += (o[0] * o[0] + o[1] * o[1]) + (o[2] * o[2] + o[3] * o[3]); }
                part += __shfl_xor(part, 16); part += __shfl_xor(part, 32);
                if (fq == 0) scr[rl * 4 + wc] = part; }
            asm volatile("" ::: "memory");
        }
        asm volatile("s_waitcnt lgkmcnt(0)" ::: "memory"); __builtin_amdgcn_s_barrier(); asm volatile("" ::: "memory");
        { const int t = tid & 255;
          if (t < 128) { const int rl = (t >> 6) * HALF + wr * 64 + (t & 63); const f32x4 p4 = *(const PG8_LAS f32x4*)(scr + rl * 4);
              ssq_out[(size_t)(u.pm * BM + rl) * 4 + u.pn] = (p4[0] + p4[1]) + (p4[2] + p4[3]); } }
        asm volatile("s_waitcnt lgkmcnt(0)" ::: "memory");
    }
};
struct PPOrder {
    int G, c;
    __device__ __forceinline__ bool next(int i, Unit& u) const {
        int idx;
        if (G == 256) { if (c < 128) { if (i >= 1) return false; idx = 384 + c; } else { if (i >= 3) return false; idx = 3 * (c - 128) + i; } }
        else { idx = i * G + c; if (idx >= 512) return false; }
        u.pm = idx >> 2; u.pn = idx & 3; return true;
    }
    __device__ __forceinline__ void a_ready(const Unit&) const {}
    __device__ __forceinline__ void done(const Unit&) const {}
};
struct EpiNull {
    static constexpr bool PERM = true, AFTER_DRAIN = false;
    __device__ __forceinline__ void operator()(const f32x4 (&acc)[2][2][4][2], const Unit& u, int wr, int wc, int fr, int fq) const {
#pragma unroll
        for (int ai = 0; ai < 2; ++ai)
#pragma unroll
            for (int bj = 0; bj < 2; ++bj)
#pragma unroll
                for (int m = 0; m < 4; ++m)
#pragma unroll
                    for (int n = 0; n < 2; ++n) asm volatile("" :: "v"(acc[ai][bj][m][n]));
    }
};
template <class Epi, class Sched, bool ALIGN_EPI = false, bool SP2 = false>
__device__ __forceinline__ void gemm_phase(PG8_LAS unsigned char* lds, const Gemm g, const Sched& S, const Epi& E, const int tid) {
    const int wid = __builtin_amdgcn_readfirstlane(tid >> 6), lane = tid & 63, wr = wid >> 2, wc = wid & 3, fr = lane & 15, fq = lane >> 4;
    const int K = g.K, nt = K / BK;
    unsigned voffA[2], voffB[2];
#pragma unroll
    for (int i = 0; i < 2; ++i) { int R, C; stage_rc(tid * 16 + i * 8192, R, C); const int Rb = Epi::PERM ? ((R & ~31) + perm32(R & 31)) : R;
        voffA[i] = (unsigned)(R * K + C) * 2u; voffB[i] = (unsigned)(Rb * K + C) * 2u; }
    const size_t kstep = (size_t)(BK * 2);
    const size_t hstep = (size_t)HALF * K * 2;
    const size_t tstep = 2 * hstep;
    const unsigned ldsw = (unsigned)wid * 1024u;
    const int aoff = lds_byte(wr * 64 + fr, fq * 8), boff = lds_byte(wc * 32 + fr, fq * 8);
#define PG8_SA(b, h) (((b) * 2 + (h)) * HTB)
#define PG8_SB(b, h) ((4 + (b) * 2 + (h)) * HTB)
#define PG8_STAGE(bufoff, gbase, voff) do { _Pragma("unroll") for (int _i = 0; _i < 2; ++_i) \
        __builtin_amdgcn_global_load_lds((const unsigned*)((const char*)(gbase) + (voff)[_i]), (PG8_LAS unsigned*)(lds + (bufoff) + ldsw + _i * 8192), 16, 0, 0); } while (0)
#define PG8_LDA(dst, b, h) do { _Pragma("unroll") for (int m = 0; m < 4; ++m) _Pragma("unroll") for (int k = 0; k < 2; ++k) dst[m][k] = *(const PG8_LAS bf16x8*)(lds + PG8_SA(b, h) + aoff + m * 2048 + k * 1024); } while (0)
#define PG8_LDB(dst, b, h) do { _Pragma("unroll") for (int n = 0; n < 2; ++n) _Pragma("unroll") for (int k = 0; k < 2; ++k) dst[n][k] = *(const PG8_LAS bf16x8*)(lds + PG8_SB(b, h) + boff + n * 2048 + k * 1024); } while (0)
#define PG8_MMA(ai, bj, At, Bt) do { __builtin_amdgcn_s_setprio(1); _Pragma("unroll") for (int m = 0; m < 4; ++m) _Pragma("unroll") for (int n = 0; n < 2; ++n) _Pragma("unroll") for (int k = 0; k < 2; ++k) \
        acc[ai][bj][m][n] = __builtin_amdgcn_mfma_f32_16x16x32_bf16(Bt[n][k], At[m][k], acc[ai][bj][m][n], 0, 0, 0); __builtin_amdgcn_s_setprio(0); } while (0)
#define PG8_WAIT_V(n) asm volatile("s_waitcnt vmcnt(" #n ")" ::: "memory")
#define PG8_WAIT_L(n) asm volatile("s_waitcnt lgkmcnt(" #n ")" ::: "memory")
#define PG8_BAR __builtin_amdgcn_s_barrier()
#define PG8_SCHED __builtin_amdgcn_sched_barrier(0)
    Unit cur, nxt; int ui = 0;
    if (!S.next(0, cur)) return;
    f32x4 acc[2][2][4][2];
#pragma unroll
    for (int a = 0; a < 2; ++a)
#pragma unroll
        for (int b = 0; b < 2; ++b)
#pragma unroll
            for (int m = 0; m < 4; ++m)
#pragma unroll
                for (int n = 0; n < 2; ++n) acc[a][b][m][n] = (f32x4){0.f, 0.f, 0.f, 0.f};
    bf16x8 At[4][2], B0[2][2], B1[2][2];
    const char* cA = (const char*)g.A + (size_t)cur.pm * tstep; const char* cB = (const char*)g.Bt + (size_t)cur.pn * tstep;
    S.a_ready(cur);
    if constexpr (SP2) {
        PG8_STAGE(PG8_SB(0, 0), cB, voffB); PG8_STAGE(PG8_SB(0, 1), cB + hstep, voffB); PG8_STAGE(PG8_SA(0, 0), cA, voffA); PG8_STAGE(PG8_SA(0, 1), cA + hstep, voffA);
        if (wr == 1) PG8_BAR;
        PG8_WAIT_V(2); PG8_BAR;
        PG8_STAGE(PG8_SB(1, 0), cB + kstep, voffB); PG8_STAGE(PG8_SA(1, 0), cA + kstep, voffA); PG8_STAGE(PG8_SB(1, 1), cB + hstep + kstep, voffB);
        PG8_WAIT_V(6); PG8_BAR;
    } else {
        PG8_STAGE(PG8_SB(0, 0), cB, voffB); PG8_STAGE(PG8_SA(0, 0), cA, voffA); PG8_STAGE(PG8_SB(0, 1), cB + hstep, voffB); PG8_STAGE(PG8_SA(0, 1), cA + hstep, voffA);
        if (wr == 1) PG8_BAR;
        PG8_WAIT_V(4); PG8_BAR;
        PG8_STAGE(PG8_SB(1, 0), cB + kstep, voffB); PG8_STAGE(PG8_SA(1, 0), cA + kstep, voffA); PG8_STAGE(PG8_SB(1, 1), cB + hstep + kstep, voffB);
        PG8_WAIT_V(6); PG8_BAR;
    }
    for (;;) {
        const bool has_next = S.next(ui + 1, nxt);
        const char* nA = has_next ? (const char*)g.A + (size_t)nxt.pm * tstep : cA; const char* nB = has_next ? (const char*)g.Bt + (size_t)nxt.pn * tstep : cB;
        for (int t = 0; t < nt; t += 2) {
            const bool last = (t == nt - 2);
            const char* a1 = cA + (size_t)(t + 1) * kstep;
            const char* a2 = last ? nA : cA + (size_t)(t + 2) * kstep; const char* b2 = last ? nB : cB + (size_t)(t + 2) * kstep;
            const char* a3 = a2 + kstep; const char* b3 = b2 + kstep;
            if (last && has_next) S.a_ready(nxt);
            if constexpr (SP2) {
            PG8_LDB(B0, 0, 0); PG8_LDB(B1, 0, 1); PG8_SCHED; PG8_LDA(At, 0, 0); PG8_STAGE(PG8_SA(1, 1), a1 + hstep, voffA);
            PG8_WAIT_V(8); PG8_WAIT_L(0); PG8_BAR; PG8_MMA(0, 0, At, B0); PG8_MMA(0, 1, At, B1); PG8_BAR; PG8_SCHED;
            PG8_LDA(At, 0, 1); PG8_STAGE(PG8_SB(0, 0), b2, voffB); PG8_STAGE(PG8_SB(0, 1), b2 + hstep, voffB); PG8_STAGE(PG8_SA(0, 0), a2, voffA);
            PG8_WAIT_V(8); PG8_WAIT_L(0); PG8_BAR; PG8_MMA(1, 0, At, B0); PG8_MMA(1, 1, At, B1); PG8_BAR; PG8_SCHED;
            PG8_LDB(B0, 1, 0); PG8_LDB(B1, 1, 1); PG8_SCHED; PG8_LDA(At, 1, 0); PG8_STAGE(PG8_SA(0, 1), a2 + hstep, voffA);
            PG8_WAIT_V(8); PG8_WAIT_L(0); PG8_BAR; PG8_MMA(0, 0, At, B0); PG8_MMA(0, 1, At, B1); PG8_BAR; PG8_SCHED;
            PG8_LDA(At, 1, 1); PG8_STAGE(PG8_SB(1, 0), b3, voffB); PG8_STAGE(PG8_SB(1, 1), b3 + hstep, voffB); PG8_STAGE(PG8_SA(1, 0), a3, voffA);
            PG8_WAIT_V(8); PG8_WAIT_L(0); PG8_BAR; PG8_MMA(1, 0, At, B0); PG8_MMA(1, 1, At, B1); PG8_BAR; PG8_SCHED;
            } else {
            PG8_LDB(B0, 0, 0); PG8_SCHED; PG8_LDA(At, 0, 0); PG8_STAGE(PG8_SA(1, 1), a1 + hstep, voffA);
            PG8_WAIT_L(8); PG8_BAR; PG8_WAIT_L(0); PG8_MMA(0, 0, At, B0); PG8_BAR; PG8_SCHED;
            PG8_LDB(B1, 0, 1); PG8_STAGE(PG8_SB(0, 0), b2, voffB);
            PG8_BAR; PG8_WAIT_L(0); PG8_MMA(0, 1, At, B1); PG8_BAR;
            PG8_LDA(At, 0, 1); PG8_STAGE(PG8_SA(0, 0), a2, voffA);
            PG8_BAR; PG8_WAIT_L(0); PG8_MMA(1, 0, At, B0); PG8_BAR; PG8_SCHED;
            PG8_STAGE(PG8_SB(0, 1), b2 + hstep, voffB);
            PG8_WAIT_V(6); PG8_BAR; PG8_MMA(1, 1, At, B1); PG8_BAR;
            PG8_LDB(B0, 1, 0); PG8_SCHED; PG8_LDA(At, 1, 0); PG8_STAGE(PG8_SA(0, 1), a2 + hstep, voffA);
            PG8_WAIT_L(8); PG8_BAR; PG8_WAIT_L(0); PG8_MMA(0, 0, At, B0); PG8_BAR; PG8_SCHED;
            PG8_LDB(B1, 1, 1); PG8_STAGE(PG8_SB(1, 0), b3, voffB);
            PG8_BAR; PG8_WAIT_L(0); PG8_MMA(0, 1, At, B1); PG8_BAR;
            PG8_LDA(At, 1, 1); PG8_STAGE(PG8_SA(1, 0), a3, voffA);
            PG8_BAR; PG8_WAIT_L(0); PG8_MMA(1, 0, At, B0); PG8_BAR; PG8_SCHED;
            PG8_STAGE(PG8_SB(1, 1), b3 + hstep, voffB);
            PG8_WAIT_V(6); PG8_BAR; PG8_MMA(1, 1, At, B1); PG8_BAR;
            }
        }
        if constexpr (ALIGN_EPI) { if (wr == 0) PG8_BAR; }
        if constexpr (!Epi::AFTER_DRAIN) { E(acc, cur, wr, wc, fr, fq); S.done(cur); }
        if (!has_next) break;
#pragma unroll
        for (int a = 0; a < 2; ++a)
#pragma unroll
            for (int b = 0; b < 2; ++b)
#pragma unroll
                for (int m = 0; m < 4; ++m)
#pragma unroll
                    for (int n = 0; n < 2; ++n) acc[a][b][m][n] = (f32x4){0.f, 0.f, 0.f, 0.f};
        cur = nxt; cA = nA; cB = nB; ++ui;
        if constexpr (ALIGN_EPI) { if (wr == 1) PG8_BAR; }
    }
    PG8_WAIT_V(0);
    if constexpr (!ALIGN_EPI) { if (wr == 0) PG8_BAR; }
    PG8_BAR;
    if constexpr (Epi::AFTER_DRAIN) { E.fused(acc, cur, wr, wc, fr, fq, lds, wid, lane); S.done(cur); }
#undef PG8_SA
#undef PG8_SB
#undef PG8_STAGE
#undef PG8_LDA
#undef PG8_LDB
#undef PG8_MMA
#undef PG8_WAIT_V
#undef PG8_WAIT_L
#undef PG8_BAR
#undef PG8_SCHED
}
}

constexpr int NWAVES = 8;
constexpr int BATCH = 4, SEQ = 8192, DM = 1024, DEPTH = 2, M = BATCH * SEQ;
constexpr int NH = 4, DK = 64, DV = 128, CHUNK = 64, NCH = SEQ / CHUNK;
constexpr int NITEM = BATCH * NH * NCH;
constexpr int IN_DIM = 3088, FFN = 2816, PLE = 256, CONVD = 512;
constexpr int NPROJ = 3328;
constexpr int PS = 2816;
constexpr int PC_Q = 0, PC_K = 256, PC_V = 512, PC_G = 1024, PC_CB = 1536, PC_U = 2048, PC_LA = 2560;
constexpr int N_PHASES = 18;

constexpr size_t MiB = 1u << 20;
constexpr size_t WS_CTL = 0, CTL_ZERO_BYTES = 1 * MiB;
constexpr size_t WS_SSQ0 = 1 * MiB, WS_SSQ1 = 1 * MiB + 512 * 1024;
constexpr size_t WS_DECAY = 2 * MiB;
constexpr size_t WS_W = 4 * MiB, W_LAYER = 28 * MiB;
constexpr size_t WO_IN = 0, WO_OUT = 6815744, WO_GU = WO_OUT + 2 * MiB, WO_DN = WO_GU + 11 * MiB, WO_PG = WO_DN + 5767168, WO_PP = WO_PG + 2 * MiB;
static_assert(WO_PP + 512 * 1024 <= W_LAYER, "weights per layer");
constexpr size_t WS_HB = 64 * MiB;
constexpr size_t WS_PROJ = 128 * MiB;
constexpr size_t WS_U = 336 * MiB;
constexpr size_t WS_S = 400 * MiB;
constexpr size_t WS_PB = 432 * MiB;
constexpr size_t WS_UB = 464 * MiB;
constexpr size_t WS_END = 496 * MiB;
constexpr int CW_BAR = 4096;

constexpr int RING_OFF = 0, RING_BYTES = 131072;
constexpr int EPI_SCR_OFF = RING_BYTES;
constexpr int RSTD_TAB_OFF = RING_BYTES + 4096;
constexpr int LDSCTL_OFF = RING_BYTES + 4096 + 8192, MISC_OFF = LDSCTL_OFF + 320;
constexpr int LDS_BYTES = 147456;
constexpr int G_TOT = 0, G_QT = 2048, G_KT = 12288, G_VT = 24576, G_ST = 45056, G_OST = 65536, G_UT = 45056;
constexpr int QK_STRIDE = 144, KD_STRIDE = 192, V_STRIDE = 320, OST_STRIDE = 528, U_STRIDE = 272;

#define GAS __attribute__((address_space(1)))
#define LAS __attribute__((address_space(3)))
typedef unsigned short bf16;
typedef unsigned v4u __attribute__((ext_vector_type(4)));
typedef unsigned v2u __attribute__((ext_vector_type(2)));
typedef float f32x4 __attribute__((ext_vector_type(4)));
typedef float f32x16 __attribute__((ext_vector_type(16)));
typedef short bf16x8 __attribute__((ext_vector_type(8)));
typedef short s16x4 __attribute__((ext_vector_type(4)));
typedef GAS unsigned gu32;
#define RLX_AGENT __ATOMIC_RELAXED, __HIP_MEMORY_SCOPE_AGENT
#define LDS_WAIT() asm volatile("s_waitcnt lgkmcnt(0)" ::: "memory")
#define VM_WAIT() asm volatile("s_waitcnt vmcnt(0)" ::: "memory")
using pg8::cvt_pk_bf16; using pg8::fast_exp; using pg8::fast_rcp; using pg8::siluf_;
__device__ __forceinline__ float bf_lo(unsigned w) { return __uint_as_float(w << 16); }
__device__ __forceinline__ float bf_hi(unsigned w) { return __uint_as_float(w & 0xffff0000u); }
__device__ __forceinline__ void unpack8(const v4u& w, float (&f)[8]) { f[0] = bf_lo(w.x); f[1] = bf_hi(w.x); f[2] = bf_lo(w.y); f[3] = bf_hi(w.y); f[4] = bf_lo(w.z); f[5] = bf_hi(w.z); f[6] = bf_lo(w.w); f[7] = bf_hi(w.w); }
__device__ __forceinline__ v4u pack8(const float (&f)[8]) { v4u w; w.x = cvt_pk_bf16(f[0], f[1]); w.y = cvt_pk_bf16(f[2], f[3]); w.z = cvt_pk_bf16(f[4], f[5]); w.w = cvt_pk_bf16(f[6], f[7]); return w; }
#define XB_TMO      128
#define XB_XCNT(j)  (256  + 64 * (j))
#define XB_XSUB(j)  (1280 + 64 * (j))
#define XB_XGEN(j)  (2304 + 64 * (j))
#define XB_TOP      3328
#define XB_TOPGEN   3392
#define XCD_BAR_WORDS 3456
#define XB_SPIN_CAP (1u << 18)

__device__ __forceinline__ unsigned xb_ld(unsigned* p)              { return __hip_atomic_load(p, __ATOMIC_RELAXED, __HIP_MEMORY_SCOPE_AGENT); }
__device__ __forceinline__ unsigned xb_add(unsigned* p, unsigned v) { return __hip_atomic_fetch_add(p, v, __ATOMIC_RELAXED, __HIP_MEMORY_SCOPE_AGENT); }
__device__ __forceinline__ unsigned xb_xcc_id() { return (unsigned)__builtin_amdgcn_s_getreg((3 << 11) | 20) & 0xFu; }
#define XB_SPIN(cond, bar) do { unsigned _sp = 0; while (cond) { __builtin_amdgcn_s_sleep(1); \
    if ((++_sp & 255u) == 0u) { if (xb_ld(&(bar)[XB_TMO])) break; if (_sp > XB_SPIN_CAP) { atomicAdd(&(bar)[XB_TMO], 1u); break; } } } } while (0)

struct XcdBarrier {
    unsigned* bar; unsigned x;
    volatile LAS unsigned* st;
};

__device__ __forceinline__ XcdBarrier xcd_barrier_post(unsigned* bar, volatile LAS unsigned* st) {
    XcdBarrier b; b.bar = bar; b.x = xb_xcc_id(); b.st = st;
    if (threadIdx.x == 0) (void)xb_add(&bar[XB_XCNT(b.x)], 1u);
    return b;
}
__device__ __forceinline__ void xcd_barrier_complete(unsigned* bar, unsigned x, unsigned& nloc, unsigned& nx) {
    const unsigned G = gridDim.x * gridDim.y * gridDim.z;
    unsigned sum, cnt, mine, sp = 0u;
    for (;;) {
        sum = 0u; cnt = 0u; mine = 0u;
#pragma unroll
        for (unsigned j = 0; j < 16; ++j) { const unsigned c = xb_ld(&bar[XB_XCNT(j)]); sum += c; cnt += (c > 0u) ? 1u : 0u; mine = (j == x) ? c : mine; }
        if (sum == G) break;
        __builtin_amdgcn_s_sleep(1);
        if ((++sp & 255u) == 0u) { if (xb_ld(&bar[XB_TMO])) break; if (sp > XB_SPIN_CAP) { atomicAdd(&bar[XB_TMO], 1u); break; } }
    }
    nloc = mine > 0u ? mine : 1u; nx = cnt > 0u ? cnt : 1u;
}

__device__ __forceinline__ void xcd_barrier(const XcdBarrier& b) {
    asm volatile("s_waitcnt vmcnt(0)" ::: "memory");
    __syncthreads();
    if (threadIdx.x == 0) {
        unsigned* bar = b.bar;
        __builtin_amdgcn_s_waitcnt(0);
        unsigned nloc = b.st[0], nx = b.st[1];
        if (nloc == 0u) { xcd_barrier_complete(bar, b.x, nloc, nx); b.st[0] = nloc; b.st[1] = nx; }
        const unsigned old = xb_add(&bar[XB_XSUB(b.x)], 1u);
        const unsigned gen = old / nloc;
        if (old + 1u == (gen + 1u) * nloc) {
            __builtin_amdgcn_fence(__ATOMIC_RELEASE, "agent");
            asm volatile("s_waitcnt vmcnt(0)" ::: "memory");
            const unsigned og = xb_add(&bar[XB_TOP], 1u);
            const unsigned tg = og / nx;
            if (og + 1u == (tg + 1u) * nx) xb_add(&bar[XB_TOPGEN], 1u);
            else XB_SPIN(xb_ld(&bar[XB_TOPGEN]) == tg, bar);
            __builtin_amdgcn_fence(__ATOMIC_ACQUIRE, "agent");
            xb_add(&bar[XB_XGEN(b.x)], 1u);
            asm volatile("s_waitcnt vmcnt(0)" ::: "memory");
        } else {
            XB_SPIN(xb_ld(&bar[XB_XGEN(b.x)]) == gen, bar);
            __builtin_amdgcn_fence(__ATOMIC_ACQUIRE, "agent");
            asm volatile("s_waitcnt vmcnt(0)" ::: "memory");
        }
    }
    __syncthreads();
}

struct Args { const float* in[16]; float* out; unsigned char* ws; int ph_lo, ph_hi; };
struct Frame {
    LAS unsigned char* lds;
    gu32* ctl;
    int tid, lane, wave;
    int G;
    const __attribute__((address_space(4))) Args* ap;
    GAS float* out; GAS unsigned char* ws;
};
__device__ __forceinline__ GAS bf16* w_ptr(const Frame& F, int L, size_t off) { return (GAS bf16*)(F.ws + WS_W + (size_t)L * W_LAYER + off); }
__device__ __forceinline__ float wave_sum(float v) {
#pragma unroll
    for (int o = 1; o < 64; o <<= 1) v += __shfl_xor(v, o);
    return v;
}
__device__ __forceinline__ s16x4 tr_read(LAS unsigned char* p) { typedef short v4i16_t __attribute__((ext_vector_type(4))); return __builtin_bit_cast(s16x4, __builtin_amdgcn_ds_read_tr16_b64_v4i16((LAS v4i16_t*)p)); }
__device__ __forceinline__ bf16x8 cat8(s16x4 lo, s16x4 hi) { return (bf16x8){lo[0], lo[1], lo[2], lo[3], hi[0], hi[1], hi[2], hi[3]}; }

struct TDesc { const GAS float* src; const GAS float* gk; GAS bf16* dst; int ldw, K; float cmul; };
constexpr int I_IN = 16 * 96, I_OUT = 16 * 32, I_GU = 16 * 176, I_DN = 44 * 32, I_PG = 16 * 32, I_PP = 4 * 32, I_LAYER = I_IN + I_OUT + I_GU + I_DN + I_PG + I_PP;
__device__ __forceinline__ TDesc tr_decode(const Frame& F, int it) {
    const int L = it / I_LAYER; int r = it % I_LAYER; TDesc d;
    if (r < I_IN) { const int kb = r / 96, nb = r % 96, n0 = 32 * nb, k0 = 64 * kb;
        const int sc = n0 < 1536 ? n0 : (n0 < 2048 ? n0 + 16 : ((((n0 - 2048) >> 7) & 1) ? 2576 : 2064) + 128 * ((n0 - 2048) >> 8) + ((n0 - 2048) & 127));
        d.src = ((const GAS float*)F.ap->in[3]) + (size_t)L * DM * IN_DIM + (size_t)k0 * IN_DIM + sc; d.gk = ((const GAS float*)F.ap->in[2]) + L * DM + k0; d.dst = w_ptr(F, L, WO_IN) + (size_t)n0 * 1024 + k0;
        d.ldw = IN_DIM; d.K = 1024; d.cmul = n0 < 256 ? 0.125f : 1.0f; return d; } r -= I_IN;
    if (r < I_OUT) { const int kb = r / 32, nb = r % 32, k0 = 64 * kb;
        d.src = ((const GAS float*)F.ap->in[8]) + (size_t)L * 1024 * 1024 + (size_t)k0 * 1024 + 32 * nb; d.gk = nullptr; d.dst = w_ptr(F, L, WO_OUT) + (size_t)(32 * nb) * 1024 + k0;
        d.ldw = 1024; d.K = 1024; d.cmul = 1.0f; return d; } r -= I_OUT;
    if (r < I_GU) { const int kb = r / 176, nb = r % 176, n0 = 32 * nb, pn = n0 >> 8, bj = (n0 >> 7) & 1, sc = bj * FFN + 128 * pn + (n0 & 127), k0 = 64 * kb;
        d.src = ((const GAS float*)F.ap->in[10]) + (size_t)L * DM * 2 * FFN + (size_t)k0 * 2 * FFN + sc; d.gk = ((const GAS float*)F.ap->in[9]) + L * DM + k0; d.dst = w_ptr(F, L, WO_GU) + (size_t)n0 * 1024 + k0;
        d.ldw = 2 * FFN; d.K = 1024; d.cmul = 1.0f; return d; } r -= I_GU;
    if (r < I_DN) { const int kb = r / 32, nb = r % 32, k0 = 64 * kb;
        d.src = ((const GAS float*)F.ap->in[11]) + (size_t)L * FFN * DM + (size_t)k0 * DM + 32 * nb; d.gk = nullptr; d.dst = w_ptr(F, L, WO_DN) + (size_t)(32 * nb) * FFN + k0;
        d.ldw = DM; d.K = FFN; d.cmul = 1.0f; return d; } r -= I_DN;
    if (r < I_PG) { const int kb = r / 32, nb = r % 32, k0 = 64 * kb;
        d.src = ((const GAS float*)F.ap->in[13]) + (size_t)L * DM * DM + (size_t)k0 * DM + 32 * nb; d.gk = ((const GAS float*)F.ap->in[12]) + L * DM + k0; d.dst = w_ptr(F, L, WO_PG) + (size_t)(32 * nb) * 1024 + k0;
        d.ldw = DM; d.K = 1024; d.cmul = 1.0f; return d; } r -= I_PG;
    { const int kb = r / 32, nb = r % 32, k0 = 64 * kb;
        d.src = ((const GAS float*)F.ap->in[14]) + (size_t)L * PLE * DM + (size_t)k0 * DM + 32 * nb; d.gk = nullptr; d.dst = w_ptr(F, L, WO_PP) + (size_t)(32 * nb) * PLE + k0;
        d.ldw = DM; d.K = PLE; d.cmul = 1.0f; return d; }
}
struct TRegs { f32x4 v[8]; float g[8]; };
__device__ __forceinline__ void tr_load(const TDesc& d, TRegs& R, int lane) {
#pragma unroll
    for (int j = 0; j < 8; ++j) { const int kk = (lane >> 3) + 8 * j; R.v[j] = __builtin_nontemporal_load((const GAS f32x4*)(d.src + (size_t)kk * d.ldw + 4 * (lane & 7))); R.g[j] = d.gk ? d.gk[kk] : 1.0f; }
}
__device__ __forceinline__ void tr_process(const TDesc& d, const TRegs& R, LAS float* scr, int lane) {
#pragma unroll
    for (int j = 0; j < 8; ++j) { const int kk = (lane >> 3) + 8 * j; const float s = R.g[j] * d.cmul; LAS float* w = scr + kk * 33 + 4 * (lane & 7);
        w[0] = R.v[j][0] * s; w[1] = R.v[j][1] * s; w[2] = R.v[j][2] * s; w[3] = R.v[j][3] * s; }
    LDS_WAIT(); asm volatile("" ::: "memory");
    const int c = lane & 7;
#pragma unroll
    for (int j = 0; j < 4; ++j) { const int n = (lane >> 3) + 8 * j; const LAS float* s = scr + (8 * c) * 33 + n;
        v4u o; o.x = cvt_pk_bf16(s[0 * 33], s[1 * 33]); o.y = cvt_pk_bf16(s[2 * 33], s[3 * 33]); o.z = cvt_pk_bf16(s[4 * 33], s[5 * 33]); o.w = cvt_pk_bf16(s[6 * 33], s[7 * 33]);
        *(GAS v4u*)(d.dst + (size_t)n * d.K + 8 * c) = o; }
    LDS_WAIT(); asm volatile("" ::: "memory");
}
__device__ __forceinline__ void p0_prologue(Frame& F) {
    LAS float* scr = (LAS float*)(F.lds + RING_OFF + F.wave * 16384);
    const int gw = blockIdx.x * NWAVES + F.wave, NGW = F.G * NWAVES;
    { int it = gw; TDesc d; TRegs R;
      if (it < DEPTH * I_LAYER) { d = tr_decode(F, it); tr_load(d, R, F.lane); }
      while (it < DEPTH * I_LAYER) { const int itn = it + NGW; TDesc dn = d; TRegs Rn = R;
          if (itn < DEPTH * I_LAYER) { dn = tr_decode(F, itn); tr_load(dn, Rn, F.lane); }
          tr_process(d, R, scr, F.lane); d = dn; R = Rn; it = itn; } }
    const int gt = blockIdx.x * (NWAVES * 64) + F.tid, NGT = F.G * NWAVES * 64;
    for (int it = gt; it < DEPTH * 256 * 128; it += NGT) {
        const int L = it >> 15, r = it & 32767, n = r >> 7, k0 = (r & 127) * 8;
        const GAS float* win = ((const GAS float*)F.ap->in[3]) + (size_t)L * DM * IN_DIM; const GAS float* wgu = ((const GAS float*)F.ap->in[4]) + (size_t)L * 16 * 256 + n; const GAS float* g1 = ((const GAS float*)F.ap->in[2]) + L * DM;
        float wg[16];
#pragma unroll
        for (int rr = 0; rr < 16; ++rr) wg[rr] = wgu[rr * 256];
        float o[8];
#pragma unroll
        for (int kk = 0; kk < 8; ++kk) { const GAS f32x4* wr_ = (const GAS f32x4*)(win + (size_t)(k0 + kk) * IN_DIM + 1536); float s = 0.f;
#pragma unroll
            for (int rr = 0; rr < 4; ++rr) { const f32x4 w4 = wr_[rr]; s += (w4[0] * wg[4 * rr] + w4[1] * wg[4 * rr + 1]) + (w4[2] * wg[4 * rr + 2] + w4[3] * wg[4 * rr + 3]); }
            o[kk] = s * g1[k0 + kk]; }
        *(GAS v4u*)(w_ptr(F, L, WO_IN) + (size_t)(3072 + n) * 1024 + k0) = pack8(o);
    }
    GAS bf16* HB = (GAS bf16*)(F.ws + WS_HB); GAS float* SSQ0 = (GAS float*)(F.ws + WS_SSQ0);
    for (int m = 2 * gw; m < M; m += 2 * NGW) {
        f32x4 v[2][4]; float s[2] = {0.f, 0.f};
#pragma unroll
        for (int rr = 0; rr < 2; ++rr) { const GAS f32x4* xr = (const GAS f32x4*)(((const GAS float*)F.ap->in[0]) + (size_t)(m + rr) * DM) + F.lane;
#pragma unroll
            for (int j = 0; j < 4; ++j) v[rr][j] = __builtin_nontemporal_load(xr + 64 * j); }
#pragma unroll
        for (int rr = 0; rr < 2; ++rr) {
#pragma unroll
            for (int j = 0; j < 4; ++j) s[rr] += (v[rr][j][0] * v[rr][j][0] + v[rr][j][1] * v[rr][j][1]) + (v[rr][j][2] * v[rr][j][2] + v[rr][j][3] * v[rr][j][3]);
            s[rr] = wave_sum(s[rr]);
            GAS v2u* o8 = (GAS v2u*)(HB + (size_t)(m + rr) * DM) + F.lane;
#pragma unroll
            for (int j = 0; j < 4; ++j) { v2u w; w.x = cvt_pk_bf16(v[rr][j][0], v[rr][j][1]); w.y = cvt_pk_bf16(v[rr][j][2], v[rr][j][3]); o8[64 * j] = w; }
            if (F.lane == 0) *(GAS f32x4*)(SSQ0 + (size_t)(m + rr) * 4) = (f32x4){s[rr], 0.f, 0.f, 0.f}; }
    }
    GAS bf16* PB = (GAS bf16*)(F.ws + WS_PB);
    constexpr size_t NP8 = (size_t)DEPTH * M * PLE / 8;
    for (size_t i = (size_t)gt; i < NP8; i += 4 * (size_t)NGT) {
        f32x4 a[4], b[4];
#pragma unroll
        for (int u = 0; u < 4; ++u) { const size_t ii = i + (size_t)u * NGT; if (ii < NP8) { const GAS f32x4* s = (const GAS f32x4*)(F.ap->in[1]) + 2 * ii; a[u] = __builtin_nontemporal_load(s); b[u] = __builtin_nontemporal_load(s + 1); } }
#pragma unroll
        for (int u = 0; u < 4; ++u) { const size_t ii = i + (size_t)u * NGT; if (ii < NP8) {
            v4u w; w.x = cvt_pk_bf16(a[u][0], a[u][1]); w.y = cvt_pk_bf16(a[u][2], a[u][3]); w.z = cvt_pk_bf16(b[u][0], b[u][1]); w.w = cvt_pk_bf16(b[u][2], b[u][3]);
            *((GAS v4u*)PB + ii) = w; } }
    }
}

__device__ __forceinline__ void gla_prefix(const v4u& la, LAS unsigned char* lds, int wid, int lane, float (&bc)[8], float (&tot)[8]) {
    float c[8]; unpack8(la, c);
#pragma unroll
    for (int off = 8; off < 64; off <<= 1)
#pragma unroll
        for (int j = 0; j < 8; ++j) { const float v = __shfl_up(c[j], off); if (lane >= off) c[j] += v; }
    LAS float* T = (LAS float*)(lds + G_TOT);
    const int d0 = 8 * (lane & 7);
    if (lane >= 56) { *(LAS f32x4*)(T + wid * 64 + d0) = (f32x4){c[0], c[1], c[2], c[3]}; *(LAS f32x4*)(T + wid * 64 + d0 + 4) = (f32x4){c[4], c[5], c[6], c[7]}; }
    LDS_WAIT(); __syncthreads();
    float off[8];
#pragma unroll
    for (int j = 0; j < 8; ++j) { off[j] = 0.f; tot[j] = 0.f; }
#pragma unroll
    for (int w = 0; w < 8; ++w) { const f32x4 a = *(LAS f32x4*)(T + w * 64 + d0), b = *(LAS f32x4*)(T + w * 64 + d0 + 4);
        const float tv[8] = {a[0], a[1], a[2], a[3], b[0], b[1], b[2], b[3]};
#pragma unroll
        for (int j = 0; j < 8; ++j) { tot[j] += tv[j]; if (w < wid) off[j] += tv[j]; } }
#pragma unroll
    for (int j = 0; j < 8; ++j) bc[j] = off[j] + c[j];
}

struct P1Regs { v4u la, kk, vv[2]; };
__device__ __forceinline__ void p1_load(P1Regs& R, const GAS bf16* PROJ, int item, int t, int d0, int tid) {
    const int bh = item >> 7, n = item & 127, b = bh >> 2, h = bh & 3; const size_t tok0 = (size_t)b * SEQ + (size_t)n * CHUNK;
    const GAS bf16* row = PROJ + (tok0 + t) * PS;
    R.la = *(const GAS v4u*)(row + PC_LA + 64 * h + d0);
    R.kk = *(const GAS v4u*)(row + PC_K + 64 * h + d0);
#pragma unroll
    for (int i = 0; i < 2; ++i) R.vv[i] = *(const GAS v4u*)(PROJ + (tok0 + 32 * i + (tid >> 4)) * PS + PC_V + 128 * h + 8 * (tid & 15));
}
__device__ __forceinline__ void gla_p1(Frame& F, int L) {
    const GAS bf16* PROJ = (const GAS bf16*)(F.ws + WS_PROJ); GAS bf16* U = (GAS bf16*)(F.ws + WS_UB); GAS float* DEC = (GAS float*)(F.ws + WS_DECAY);
    LAS unsigned char* lds = F.lds + RING_OFF; const int wid = F.wave, lane = F.lane, tid = F.tid;
    const int t = 8 * wid + (lane >> 3), d0 = 8 * (lane & 7);
    const int r = lane & 31, hh = lane >> 5, g1 = (lane >> 4) & 1, q = (lane & 15) >> 2, p = lane & 3;
    const int dkt = wid >> 2, dvt = wid & 3;
    P1Regs R, Rn;
    if ((int)blockIdx.x < NITEM) p1_load(R, PROJ, blockIdx.x, t, d0, tid);
    if ((int)blockIdx.x + F.G < NITEM) p1_load(Rn, PROJ, blockIdx.x + F.G, t, d0, tid);
    for (int item = blockIdx.x; item < NITEM; item += F.G) {
#pragma unroll
        for (int i = 0; i < 2; ++i) *(LAS v4u*)(lds + G_VT + (32 * i + (tid >> 4)) * V_STRIDE + (tid & 15) * 16) = R.vv[i];
        float bc[8], tot[8]; gla_prefix(R.la, lds, wid, lane, bc, tot);
        float kf[8]; unpack8(R.kk, kf);
#pragma unroll
        for (int j = 0; j < 8; ++j) kf[j] *= fast_exp(tot[j] - bc[j]);
        *(LAS v4u*)(lds + G_KT + t * KD_STRIDE + d0 * 2) = pack8(kf);
        if (tid < 8) { GAS f32x4* dp = (GAS f32x4*)(DEC + (size_t)item * 64 + d0); dp[0] = (f32x4){fast_exp(tot[0]), fast_exp(tot[1]), fast_exp(tot[2]), fast_exp(tot[3])}; dp[1] = (f32x4){fast_exp(tot[4]), fast_exp(tot[5]), fast_exp(tot[6]), fast_exp(tot[7])}; }
        R = Rn;
        if (item + 2 * F.G < NITEM) p1_load(Rn, PROJ, item + 2 * F.G, t, d0, tid);
        LDS_WAIT(); __syncthreads();
        f32x16 acc;
#pragma unroll
        for (int i = 0; i < 16; ++i) acc[i] = 0.f;
#pragma unroll
        for (int ks = 0; ks < 4; ++ks) { const int rw = 16 * ks + 8 * hh + q;
            LAS unsigned char* ap = lds + G_KT + rw * KD_STRIDE + (32 * dkt + 16 * g1 + 4 * p) * 2;
            LAS unsigned char* bp = lds + G_VT + rw * V_STRIDE + (32 * dvt + 16 * g1 + 4 * p) * 2;
            const bf16x8 a = cat8(tr_read(ap), tr_read(ap + 4 * KD_STRIDE)), bb = cat8(tr_read(bp), tr_read(bp + 4 * V_STRIDE));
            acc = __builtin_amdgcn_mfma_f32_32x32x16_bf16(a, bb, acc, 0, 0, 0); }
        { LAS unsigned short* up = (LAS unsigned short*)(lds + G_UT + (32 * dkt + 4 * hh) * U_STRIDE) + 32 * dvt + r;
#pragma unroll
          for (int i = 0; i < 16; i += 2) { const unsigned w = cvt_pk_bf16(acc[i], acc[i + 1]);
              up[((i & 3) + 8 * (i >> 2)) * (U_STRIDE / 2)] = (unsigned short)(w & 0xffffu); up[(((i + 1) & 3) + 8 * ((i + 1) >> 2)) * (U_STRIDE / 2)] = (unsigned short)(w >> 16); } }
        LDS_WAIT(); __syncthreads();
        { const int row = tid >> 3, sg = tid & 7; const LAS v4u* sp = (const LAS v4u*)(lds + G_UT + row * U_STRIDE + sg * 32); const v4u a = sp[0], b2 = sp[1];
          GAS v4u* gp = (GAS v4u*)(U + (size_t)item * 8192 + row * 128 + sg * 16); gp[0] = a; gp[1] = b2; }
    }
}

__device__ __forceinline__ void gla_p2(Frame& F, int L) {
    if (F.wave < 4) {
        const GAS unsigned* U = (const GAS unsigned*)(F.ws + WS_UB); const GAS float* DEC = (const GAS float*)(F.ws + WS_DECAY); GAS unsigned* S = (GAS unsigned*)(F.ws + WS_S);
        for (int e = blockIdx.x * 256 + F.tid; e < BATCH * NH * 4096; e += F.G * 256) {
            const int bh = e >> 12, idx = e & 4095, dk = idx >> 6;
            const GAS unsigned* Up = U + (size_t)bh * NCH * 4096 + idx; const GAS float* dp = DEC + (size_t)bh * NCH * 64 + dk; GAS unsigned* Sp = S + (size_t)bh * NCH * 4096 + idx;
            float s0 = 0.f, s1 = 0.f;
            for (int n0 = 0; n0 < NCH; n0 += 16) {
                unsigned u[16]; float d[16];
#pragma unroll
                for (int i = 0; i < 16; ++i) { u[i] = Up[(size_t)(n0 + i) * 4096]; d[i] = dp[(n0 + i) * 64]; }
#pragma unroll
                for (int i = 0; i < 16; ++i) { Sp[(size_t)(n0 + i) * 4096] = cvt_pk_bf16(s0, s1); s0 = d[i] * s0 + bf_lo(u[i]); s1 = d[i] * s1 + bf_hi(u[i]); }
            }
        }
    } else {
        const GAS bf16* PROJ = (const GAS bf16*)(F.ws + WS_PROJ); GAS bf16* MIX = (GAS bf16*)(F.ws + WS_U);
        const GAS float* cw = ((const GAS float*)F.ap->in[6]) + (size_t)L * 3 * CONVD;
        const int t2 = F.tid - 256, c = 8 * (t2 & 63), tq = t2 >> 6;
        float w0[8], w1[8], w2[8];
        { const f32x4 a = *(const GAS f32x4*)(cw + c), b2 = *(const GAS f32x4*)(cw + c + 4); w0[0] = a[0]; w0[1] = a[1]; w0[2] = a[2]; w0[3] = a[3]; w0[4] = b2[0]; w0[5] = b2[1]; w0[6] = b2[2]; w0[7] = b2[3]; }
        { const f32x4 a = *(const GAS f32x4*)(cw + CONVD + c), b2 = *(const GAS f32x4*)(cw + CONVD + c + 4); w1[0] = a[0]; w1[1] = a[1]; w1[2] = a[2]; w1[3] = a[3]; w1[4] = b2[0]; w1[5] = b2[1]; w1[6] = b2[2]; w1[7] = b2[3]; }
        { const f32x4 a = *(const GAS f32x4*)(cw + 2 * CONVD + c), b2 = *(const GAS f32x4*)(cw + 2 * CONVD + c + 4); w2[0] = a[0]; w2[1] = a[1]; w2[2] = a[2]; w2[3] = a[3]; w2[4] = b2[0]; w2[5] = b2[1]; w2[6] = b2[2]; w2[7] = b2[3]; }
        for (int blk = blockIdx.x; blk < M / 128; blk += F.G) {
            const size_t m0 = (size_t)blk * 128 + 32 * tq;
            float u1[8], u2[8];
            if ((m0 & (SEQ - 1)) == 0) {
#pragma unroll
                for (int j = 0; j < 8; ++j) { u1[j] = 0.f; u2[j] = 0.f; }
            } else {
                const v4u a1 = *(const GAS v4u*)(PROJ + (m0 - 1) * PS + PC_U + c), a2 = *(const GAS v4u*)(PROJ + (m0 - 2) * PS + PC_U + c);
                unpack8(a1, u1); unpack8(a2, u2);
            }
            for (int g0 = 0; g0 < 32; g0 += 8) {
                v4u wu[8], wb[8];
#pragma unroll
                for (int i = 0; i < 8; ++i) { const GAS bf16* rp = PROJ + (m0 + g0 + i) * PS; wu[i] = *(const GAS v4u*)(rp + PC_U + c); wb[i] = *(const GAS v4u*)(rp + PC_CB + c); }
#pragma unroll
                for (int i = 0; i < 8; ++i) { float fu[8], fb[8], y[8]; unpack8(wu[i], fu); unpack8(wb[i], fb);
#pragma unroll
                    for (int j = 0; j < 8; ++j) { const float u0 = fu[j]; y[j] = fb[j] * (w0[j] * u2[j] + w1[j] * u1[j] + w2[j] * u0); u2[j] = u1[j]; u1[j] = u0; }
                    *(GAS v4u*)(MIX + (m0 + g0 + i) * 1024 + 512 + c) = pack8(y); }
            }
        }
    }
}

struct P3Regs { v4u la, qq, kk, vv[2], ss[2], gw[2]; };
__device__ __forceinline__ void p3_load(P3Regs& R, const GAS bf16* PROJ, const GAS bf16* S, int item, int t, int d0, int tid) {
    const int bh = item >> 7, n = item & 127, b = bh >> 2, h = bh & 3; const size_t tok0 = (size_t)b * SEQ + (size_t)n * CHUNK;
    const GAS bf16* row = PROJ + (tok0 + t) * PS;
    R.la = *(const GAS v4u*)(row + PC_LA + 64 * h + d0);
    R.qq = *(const GAS v4u*)(row + PC_Q + 64 * h + d0);
    R.kk = *(const GAS v4u*)(row + PC_K + 64 * h + d0);
#pragma unroll
    for (int i = 0; i < 2; ++i) { R.vv[i] = *(const GAS v4u*)(PROJ + (tok0 + 32 * i + (tid >> 4)) * PS + PC_V + 128 * h + 8 * (tid & 15));
                                  R.ss[i] = *(const GAS v4u*)(S + (size_t)item * 8192 + (size_t)(32 * i + (tid >> 4)) * 128 + 8 * (tid & 15)); }
    const GAS bf16* grow = PROJ + (tok0 + (tid >> 3)) * PS + PC_G + 128 * h + 16 * (tid & 7);
    R.gw[0] = *(const GAS v4u*)(grow); R.gw[1] = *(const GAS v4u*)(grow + 8);
}
__device__ __forceinline__ void gla_p3(Frame& F, int L) {
    const GAS bf16* PROJ = (const GAS bf16*)(F.ws + WS_PROJ); const GAS bf16* S = (const GAS bf16*)(F.ws + WS_S); GAS bf16* MIX = (GAS bf16*)(F.ws + WS_U);
    const GAS float* gn = ((const GAS float*)F.ap->in[7]) + L * DV;
    LAS unsigned char* lds = F.lds + RING_OFF; const int wid = F.wave, lane = F.lane, tid = F.tid;
    const int t = 8 * wid + (lane >> 3), d0 = 8 * (lane & 7);
    const int r = lane & 31, hh = lane >> 5, g1 = (lane >> 4) & 1, q = (lane & 15) >> 2, p = lane & 3;
    const int tt = wid >> 2, dvt = wid & 3;
    f32x4 gnv[4];
#pragma unroll
    for (int i = 0; i < 4; ++i) gnv[i] = *(const GAS f32x4*)(gn + 16 * (tid & 7) + 4 * i);
    P3Regs R, Rn;
    if ((int)blockIdx.x < NITEM) p3_load(R, PROJ, S, blockIdx.x, t, d0, tid);
    if ((int)blockIdx.x + F.G < NITEM) p3_load(Rn, PROJ, S, blockIdx.x + F.G, t, d0, tid);
    for (int item = blockIdx.x; item < NITEM; item += F.G) {
        const int bh = item >> 7, n = item & 127, b = bh >> 2, h = bh & 3; const size_t tok0 = (size_t)b * SEQ + (size_t)n * CHUNK;
#pragma unroll
        for (int i = 0; i < 2; ++i) { *(LAS v4u*)(lds + G_VT + (32 * i + (tid >> 4)) * V_STRIDE + (tid & 15) * 16) = R.vv[i];
                                      *(LAS v4u*)(lds + G_ST + (32 * i + (tid >> 4)) * V_STRIDE + (tid & 15) * 16) = R.ss[i]; }
        float bc[8], tot[8]; gla_prefix(R.la, lds, wid, lane, bc, tot);
        { float qf[8], kf[8]; unpack8(R.qq, qf); unpack8(R.kk, kf);
#pragma unroll
          for (int j = 0; j < 8; ++j) { const float e = fast_exp(bc[j]); qf[j] *= e; kf[j] *= fast_rcp(e); }
          *(LAS v4u*)(lds + G_QT + t * QK_STRIDE + d0 * 2) = pack8(qf);
          *(LAS v4u*)(lds + G_KT + t * QK_STRIDE + d0 * 2) = pack8(kf); }
        const v4u gw0 = R.gw[0], gw1 = R.gw[1];
        R = Rn;
        if (item + 2 * F.G < NITEM) p3_load(Rn, PROJ, S, item + 2 * F.G, t, d0, tid);
        LDS_WAIT(); __syncthreads();
        f32x16 o;
#pragma unroll
        for (int i = 0; i < 16; ++i) o[i] = 0.f;
        bf16x8 qfr[4];
#pragma unroll
        for (int ks = 0; ks < 4; ++ks) qfr[ks] = *(LAS bf16x8*)(lds + G_QT + (32 * tt + r) * QK_STRIDE + (16 * ks + 8 * hh) * 2);
#pragma unroll
        for (int ks = 0; ks < 4; ++ks) { LAS unsigned char* bp = lds + G_ST + (16 * ks + 8 * hh + q) * V_STRIDE + (32 * dvt + 16 * g1 + 4 * p) * 2;
            const bf16x8 sb = cat8(tr_read(bp), tr_read(bp + 4 * V_STRIDE));
            o = __builtin_amdgcn_mfma_f32_32x32x16_bf16(qfr[ks], sb, o, 0, 0, 0); }
        for (int st = 0; st <= tt; ++st) {
            f32x16 x;
#pragma unroll
            for (int i = 0; i < 16; ++i) x[i] = 0.f;
#pragma unroll
            for (int ks = 0; ks < 4; ++ks) { const bf16x8 ka = *(LAS bf16x8*)(lds + G_KT + (32 * st + r) * QK_STRIDE + (16 * ks + 8 * hh) * 2);
                x = __builtin_amdgcn_mfma_f32_32x32x16_bf16(ka, qfr[ks], x, 0, 0, 0); }
            if (st == tt) {
#pragma unroll
                for (int i = 0; i < 16; ++i) { const int sl = (i & 3) + 8 * (i >> 2) + 4 * hh; if (sl > r) x[i] = 0.f; } }
#pragma unroll
            for (int k2 = 0; k2 < 2; ++k2) {
                v4u pw; pw.x = cvt_pk_bf16(x[8 * k2 + 0], x[8 * k2 + 1]); pw.y = cvt_pk_bf16(x[8 * k2 + 2], x[8 * k2 + 3]); pw.z = cvt_pk_bf16(x[8 * k2 + 4], x[8 * k2 + 5]); pw.w = cvt_pk_bf16(x[8 * k2 + 6], x[8 * k2 + 7]);
                LAS unsigned char* bp = lds + G_VT + (32 * st + 16 * k2 + 4 * hh + q) * V_STRIDE + (32 * dvt + 16 * g1 + 4 * p) * 2;
                const bf16x8 vb = cat8(tr_read(bp), tr_read(bp + 8 * V_STRIDE));
                o = __builtin_amdgcn_mfma_f32_32x32x16_bf16(__builtin_bit_cast(bf16x8, pw), vb, o, 0, 0, 0); }
        }
        { LAS float* op = (LAS float*)(lds + G_OST + (32 * tt + 4 * hh) * OST_STRIDE) + 32 * dvt + r;
#pragma unroll
          for (int i = 0; i < 16; ++i) op[((i & 3) + 8 * (i >> 2)) * (OST_STRIDE / 4)] = o[i]; }
        LDS_WAIT(); __syncthreads();
        { const int trw = tid >> 3, sg = tid & 7; const LAS f32x4* op = (const LAS f32x4*)(lds + G_OST + trw * OST_STRIDE + sg * 64);
          f32x4 ov[4]; float ssq = 0.f;
#pragma unroll
          for (int i = 0; i < 4; ++i) { ov[i] = op[i]; ssq += (ov[i][0] * ov[i][0] + ov[i][1] * ov[i][1]) + (ov[i][2] * ov[i][2] + ov[i][3] * ov[i][3]); }
          ssq += __shfl_xor(ssq, 1); ssq += __shfl_xor(ssq, 2); ssq += __shfl_xor(ssq, 4);
          const float rs = __builtin_amdgcn_rsqf(ssq * (1.0f / DV) + pg8::RMS_EPS);
          float gf[16]; { float a8[8]; unpack8(gw0, a8);
#pragma unroll
              for (int j = 0; j < 8; ++j) gf[j] = a8[j];
              unpack8(gw1, a8);
#pragma unroll
              for (int j = 0; j < 8; ++j) gf[8 + j] = a8[j]; }
          float res[16];
#pragma unroll
          for (int i = 0; i < 4; ++i)
#pragma unroll
              for (int j = 0; j < 4; ++j) res[4 * i + j] = ov[i][j] * rs * gnv[i][j] * siluf_(gf[4 * i + j]);
          GAS bf16* mrow = MIX + (tok0 + trw) * 1024 + 128 * h + 16 * sg;
          { float a8[8];
#pragma unroll
            for (int j = 0; j < 8; ++j) a8[j] = res[j];
            *(GAS v4u*)(mrow) = pack8(a8);
#pragma unroll
            for (int j = 0; j < 8; ++j) a8[j] = res[8 + j];
            *(GAS v4u*)(mrow + 8) = pack8(a8); } }
    }
}

__device__ __forceinline__ void final_norm(Frame& F, const GAS float* ssq) {
    const int gw = blockIdx.x * NWAVES + F.wave, NGW = F.G * NWAVES;
    static_assert((DEPTH & 1) == 0, "the final residual stream must sit in d_ws (buffer 0), not in d_out");
    const GAS bf16* HB = (const GAS bf16*)(F.ws + WS_HB);
    f32x4 gv[4];
#pragma unroll
    for (int j = 0; j < 2; ++j) { gv[2 * j] = *((const GAS f32x4*)(((const GAS float*)F.ap->in[15]) + 512 * j + 8 * F.lane)); gv[2 * j + 1] = *((const GAS f32x4*)(((const GAS float*)F.ap->in[15]) + 512 * j + 8 * F.lane + 4)); }
    for (int m = gw; m < M; m += NGW) {
        const float rs = pg8::rstd_from(ssq, m);
        const GAS bf16* hr = HB + (size_t)m * DM + 8 * F.lane; GAS float* orow = F.out + (size_t)m * DM + 8 * F.lane;
#pragma unroll
        for (int j = 0; j < 2; ++j) { const v4u w = *(const GAS v4u*)(hr + 512 * j); float f[8]; unpack8(w, f);
            *(GAS f32x4*)(orow + 512 * j) = (f32x4){f[0], f[1], f[2], f[3]} * rs * gv[2 * j];
            *(GAS f32x4*)(orow + 512 * j + 4) = (f32x4){f[4], f[5], f[6], f[7]} * rs * gv[2 * j + 1]; }
    }
}

#ifndef REP_KIND
#define REP_KIND -1
#define REP_N 1
#endif
#ifndef STAGGER_TICKS
#define STAGGER_TICKS 0
#endif
#define STAGGER() do { if (STAGGER_TICKS > 0 && ((blockIdx.x >> 3) & 1)) { const unsigned long long t0_ = __builtin_amdgcn_s_memrealtime(); while (__builtin_amdgcn_s_memrealtime() - t0_ < (unsigned long long)STAGGER_TICKS) __builtin_amdgcn_s_sleep(8); } } while (0)
#ifndef PH_MASK
#define PH_MASK 4095
#endif
__global__ void __launch_bounds__(NWAVES * 64, 2) mega_fwd(Args args) {
    extern __shared__ __attribute__((aligned(16))) unsigned char lds[];
    Frame F;
    F.lds = (LAS unsigned char*)lds;
    F.tid = threadIdx.x; F.lane = F.tid & 63; F.wave = __builtin_amdgcn_readfirstlane(F.tid >> 6);
    F.G = gridDim.x;
    F.ws = (GAS unsigned char*)args.ws; F.out = (GAS float*)args.out; F.ctl = (gu32*)(args.ws + WS_CTL);
    F.ap = (const __attribute__((address_space(4))) Args*)__builtin_amdgcn_kernarg_segment_ptr();
    for (int u = F.tid; u < (LDS_BYTES - LDSCTL_OFF) / 4; u += NWAVES * 64) ((LAS unsigned*)(F.lds + LDSCTL_OFF))[u] = 0u;
    __syncthreads();
    const int lo = args.ph_lo, hi = args.ph_hi;
    XcdBarrier bar; bar.bar = (unsigned*)(F.ctl + CW_BAR); bar.x = 0; bar.st = (volatile LAS unsigned*)(F.lds + MISC_OFF + 32);
    if (hi - lo > 1) bar = xcd_barrier_post((unsigned*)(F.ctl + CW_BAR), (volatile LAS unsigned*)(F.lds + MISC_OFF + 32));

    PG8_LAS float* escr = (PG8_LAS float*)(F.lds + EPI_SCR_OFF); PG8_LAS unsigned char* rtab = F.lds + RSTD_TAB_OFF;

    for (int ph = lo; ph < hi; ++ph) {
        const int kind_ = (ph == 0) ? 100 : (ph == N_PHASES - 1) ? 101 : ((ph - 1) & 7);
        #ifdef PROBE_ZERO_D
        const int nrep = (kind_ == REP_KIND && ph <= 8) ? REP_N : 1;
#elif defined(PROBE_NULL_C)
        const int nrep = (kind_ == REP_KIND) ? REP_N : 1;
#else
        const int nrep = (kind_ == REP_KIND && !(kind_ == 4 && ph > 8)) ? REP_N : 1;
#endif
        for (int rep = 0; rep < nrep; ++rep) {
        { int t_ = threadIdx.x; asm volatile("" : "+v"(t_)); F.tid = t_; F.lane = t_ & 63; F.wave = __builtin_amdgcn_readfirstlane(t_ >> 6);
          const __attribute__((address_space(4))) Args* a_ = (const __attribute__((address_space(4))) Args*)__builtin_amdgcn_kernarg_segment_ptr(); asm volatile("" : "+s"(a_)); F.ap = a_;
          GAS unsigned char* w_ = (GAS unsigned char*)args.ws; asm volatile("" : "+s"(w_)); F.ws = w_; GAS float* o_ = (GAS float*)args.out; asm volatile("" : "+s"(o_)); F.out = o_; }
        GAS bf16* HB0 = (GAS bf16*)(F.ws + WS_HB); GAS bf16* HB1 = (GAS bf16*)F.out + (size_t)M * DM; GAS bf16* PROJ = (GAS bf16*)(F.ws + WS_PROJ); GAS bf16* MIX = (GAS bf16*)(F.ws + WS_U); GAS bf16* PB = (GAS bf16*)(F.ws + WS_PB);
        GAS float* SSQ[2] = {(GAS float*)(F.ws + WS_SSQ0), (GAS float*)(F.ws + WS_SSQ1)};
        if (ph == 0) { if (PH_MASK & 1) p0_prologue(F); }
        else if (ph == N_PHASES - 1) { if (PH_MASK & 2) final_norm(F, SSQ[0]); }
        else {
            const int L = (ph - 1) >> 3, s = (ph - 1) & 7;
            GAS float* sA = SSQ[L & 1]; GAS float* sB = SSQ[(L & 1) ^ 1];
            GAS bf16* HB = (L & 1) ? HB1 : HB0; GAS bf16* HBN = (L & 1) ? HB0 : HB1;
            if (s == 0) { if (PH_MASK & 4) {
                pg8::Gemm g{(const bf16*)HB, (const bf16*)w_ptr(F, L, WO_IN), M, NPROJ, 1024}; pg8::RstdOrder S; S.init(M, NPROJ, F.G, (int)blockIdx.x); S.ssq = sA; S.tab = rtab; S.tid = F.tid; S.cnt = 0;
                STAGGER();
                pg8::EpiProj E{PROJ, PS, rtab, ((const GAS float*)F.ap->in[5]) + L * 256, 0};
#ifdef PROBE_NULL_A
                if (rep + 1 < nrep) { pg8::EpiNull E0; pg8::gemm_phase<pg8::EpiNull, pg8::RstdOrder, true, true>(F.lds + RING_OFF, g, S, E0, F.tid); } else
#endif
                pg8::gemm_phase<pg8::EpiProj, pg8::RstdOrder, true, true>(F.lds + RING_OFF, g, S, E, F.tid); }
                { int t_ = F.tid; asm volatile("" : "+v"(t_)); F.tid = t_; }
                if (PH_MASK & 1024) { int kp_ = PLE; asm volatile("" : "+s"(kp_)); pg8::Gemm g{(const bf16*)(PB + (size_t)L * M * PLE), (const bf16*)w_ptr(F, L, WO_PP), M, 1024, kp_};
                  pg8::PPOrder S{F.G, (int)blockIdx.x}; pg8::EpiPP E{(GAS bf16*)F.out, 1024};
                  pg8::gemm_phase<pg8::EpiPP, pg8::PPOrder, true, true>(F.lds + RING_OFF, g, S, E, F.tid); }
            } else if (s == 1) { if (PH_MASK & 8) gla_p1(F, L); }
            else if (s == 2) { if (PH_MASK & 16) gla_p2(F, L); }
            else if (s == 3) { if (PH_MASK & 32) gla_p3(F, L); }
            else if (s == 4) { if (PH_MASK & 64) {
                pg8::Gemm g{(const bf16*)MIX, (const bf16*)w_ptr(F, L, WO_OUT), M, 1024, 1024}; pg8::StaticOrder S; S.init(M, 1024, F.G, (int)blockIdx.x);
                pg8::EpiRes<0> E{nullptr, HB, HB, sB, rtab, nullptr, escr, F.tid, 0};
#ifdef PROBE_NULL_C
                if (rep + 1 < nrep) { pg8::EpiNull E0; pg8::gemm_phase<pg8::EpiNull, pg8::StaticOrder, true, true>(F.lds + RING_OFF, g, S, E0, F.tid); } else
#endif
                pg8::gemm_phase<pg8::EpiRes<0>, pg8::StaticOrder, true, true>(F.lds + RING_OFF, g, S, E, F.tid); }
            } else if (s == 5) { if (PH_MASK & 128) {
                pg8::Gemm g{(const bf16*)HB, (const bf16*)w_ptr(F, L, WO_GU), M, 2 * FFN, 1024}; pg8::RstdOrder S; S.init(M, 2 * FFN, F.G, (int)blockIdx.x); S.ssq = sB; S.tab = rtab; S.tid = F.tid; S.cnt = 0;
                STAGGER();
#if defined(PROBE_ZERO_D) && PROBE_ZERO_D == 1
                if (rep + 1 < nrep) g.A = (const bf16*)HB1;
#endif
                pg8::EpiSwiGLU E{PROJ, FFN, rtab, 0};
#ifdef PROBE_NORS_D
                if (rep + 1 < nrep) { pg8::EpiSwiGLU_<true> E0{PROJ, FFN, rtab, 0}; pg8::gemm_phase<pg8::EpiSwiGLU_<true>, pg8::RstdOrder, true, true>(F.lds + RING_OFF, g, S, E0, F.tid); } else
#endif
                pg8::gemm_phase<pg8::EpiSwiGLU, pg8::RstdOrder, true, true>(F.lds + RING_OFF, g, S, E, F.tid); }
            } else if (s == 6) { if (PH_MASK & 256) {
                pg8::Gemm g{(const bf16*)PROJ, (const bf16*)w_ptr(F, L, WO_DN), M, 1024, FFN}; pg8::StaticOrder S; S.init(M, 1024, F.G, (int)blockIdx.x);
                pg8::EpiRes<0> E{nullptr, HB, HB, sA, rtab, nullptr, escr, F.tid, 0};
#ifdef PROBE_NULL_E
                if (rep + 1 < nrep) { pg8::EpiNull E0; pg8::gemm_phase<pg8::EpiNull, pg8::StaticOrder, true, true>(F.lds + RING_OFF, g, S, E0, F.tid); } else
#endif
                pg8::gemm_phase<pg8::EpiRes<0>, pg8::StaticOrder, true, true>(F.lds + RING_OFF, g, S, E, F.tid); }
            } else { if (PH_MASK & 512) {
                if (PH_MASK & 2048) { pg8::Gemm g{(const bf16*)HB, (const bf16*)w_ptr(F, L, WO_PG), M, 1024, 1024}; pg8::RstdOrder S; S.init(M, 1024, F.G, (int)blockIdx.x); S.ssq = sA; S.tab = rtab; S.tid = F.tid; S.cnt = 0;
                  pg8::EpiRes<1> E{nullptr, HB, HBN, sB, rtab, (const GAS bf16*)F.out, escr, F.tid, 0};
#ifdef PROBE_NULL_F
                  if (rep + 1 < nrep) { pg8::EpiNull E0; pg8::gemm_phase<pg8::EpiNull, pg8::RstdOrder, true, true>(F.lds + RING_OFF, g, S, E0, F.tid); } else
#endif
                  pg8::gemm_phase<pg8::EpiRes<1>, pg8::RstdOrder, true, true>(F.lds + RING_OFF, g, S, E, F.tid); } }
            }
        }
        if (rep + 1 < nrep) xcd_barrier(bar);
        }
        if (ph + 1 < hi) xcd_barrier(bar);
#ifdef PROBE_XBAR
        if (ph + 1 < hi) { xcd_barrier(bar); xcd_barrier(bar); }
#endif
    }
}

#ifndef MK_ONE_LAUNCH
#define MK_ONE_LAUNCH 1
#endif
extern "C" void kernel_launch(void* const* d_in, const int* in_sizes, int n_in, void* d_out, int out_size, void* d_ws, size_t ws_size, hipStream_t stream) {
    static int grid = 0;
    if (grid == 0) {
        if (n_in != 16 || in_sizes[0] != M * DM || out_size != M * DM || ws_size < WS_END) { fprintf(stderr, "kernel_launch: unexpected shapes / workspace (%d inputs, in0 %d, out %d, ws %zu)\n", n_in, n_in > 0 ? in_sizes[0] : -1, out_size, ws_size); grid = -1; return; }
        int dev = 0, cus = 0, per_cu = 0;
        if (hipGetDevice(&dev) != hipSuccess || hipDeviceGetAttribute(&cus, hipDeviceAttributeMultiprocessorCount, dev) != hipSuccess) { grid = -1; return; }
        if (hipFuncSetAttribute((const void*)mega_fwd, hipFuncAttributeMaxDynamicSharedMemorySize, LDS_BYTES) != hipSuccess) { fprintf(stderr, "kernel_launch: hipFuncSetAttribute failed\n"); grid = -1; return; }
        if (hipOccupancyMaxActiveBlocksPerMultiprocessor(&per_cu, (const void*)mega_fwd, NWAVES * 64, LDS_BYTES) != hipSuccess || per_cu < 1) { fprintf(stderr, "kernel_launch: occupancy query says %d blocks per CU\n", per_cu); (void)hipGetLastError(); grid = -1; return; }
        grid = cus;
    }
    if (grid < 0) return;
    (void)hipMemsetAsync((char*)d_ws + WS_CTL, 0, CTL_ZERO_BYTES, stream);
#ifdef PROBE_ZERO_D
    (void)hipMemsetAsync((char*)d_out + (size_t)M * DM * 2, 0, (size_t)M * DM * 2, stream);
#endif
    Args a{};
    for (int i = 0; i < 16; ++i) a.in[i] = (const float*)d_in[i];
    a.out = (float*)d_out; a.ws = (unsigned char*)d_ws;
#if MK_ONE_LAUNCH
    a.ph_lo = 0; a.ph_hi = N_PHASES;
    void* kargs[] = {&a};
    hipError_t e = hipLaunchCooperativeKernel((const void*)mega_fwd, dim3(grid), dim3(NWAVES * 64), kargs, LDS_BYTES, stream);
    if (e != hipSuccess) fprintf(stderr, "kernel_launch: cooperative launch failed: %s (grid %d)\n", hipGetErrorString(e), grid);
#else
    for (int ph = 0; ph < N_PHASES; ++ph) { a.ph_lo = ph; a.ph_hi = ph + 1; hipLaunchKernelGGL(mega_fwd, dim3(grid), dim3(NWAVES * 64), LDS_BYTES, stream, a); }
#endif
}
```
